# Optimizing an MI355X kernel written in HIP

```python
import math
import jax, jax.numpy as jnp
from jax import lax
import numpy as np

D_MODEL = 4096
BATCH = 1
SEQ = 16384
DEPTH = 1
DEC_BATCH = 4
DEC_SEQ = 4096
PAST_LEN = 128

RET_HEADS = D_MODEL // 512
RET_QK_DIM = 128
RET_V_DIM = 256
RET_CHUNK = 128
RET_ROT_BASE = 10000.0
DIFF_HEADS = D_MODEL // 512
DIFF_QK_DIM = 128
DIFF_V_DIM = 256
DIFF_ROT_DIM = DIFF_QK_DIM // 4
ROPE_THETA = 500000.0
Q_BLOCK = 128
D_FF = ((8 * D_MODEL // 3 + 255) // 256) * 256
DEEPNORM_ALPHA = (2.0 * DEPTH) ** 0.25
DEEPNORM_BETA = (8.0 * DEPTH) ** -0.25
LN_EPS = 1e-5
GN_EPS = 1e-6
RMS_EPS = 1e-5

RQ_COLS = RET_HEADS * RET_QK_DIM
RK_COLS = RET_HEADS * RET_QK_DIM
RV_COLS = RET_HEADS * RET_V_DIM
RG_COLS = RET_HEADS * RET_V_DIM
DQ_COLS = DIFF_HEADS * 2 * DIFF_QK_DIM
DK_COLS = DIFF_HEADS * 2 * DIFF_QK_DIM
DV_COLS = DIFF_HEADS * DIFF_V_DIM
IN_COLS = RQ_COLS + RK_COLS + RV_COLS + RG_COLS + DQ_COLS + DK_COLS + DV_COLS
MIX_WIDTH = RV_COLS + DV_COLS

kernel_name = 'hybrid_retention_diffattn_deepnorm_encoder'


def layer_norm(x, g, b):
    xf = x.astype(jnp.float32)
    mu = jnp.mean(xf, axis=-1, keepdims=True)
    var = jnp.mean(jnp.square(xf - mu), axis=-1, keepdims=True)
    return ((xf - mu) * lax.rsqrt(var + LN_EPS) * g.astype(jnp.float32) + b.astype(jnp.float32)).astype(x.dtype)


def apply_rope(x, pos, rot_dim, base):
    inv_freq = base ** (-jnp.arange(0, rot_dim, 2, dtype=jnp.float32) / rot_dim)
    ang = pos[:, None] * inv_freq[None, :]
    cos = jnp.concatenate([jnp.cos(ang), jnp.cos(ang)], axis=-1)
    sin = jnp.concatenate([jnp.sin(ang), jnp.sin(ang)], axis=-1)
    half = rot_dim // 2
    xr = x[..., :rot_dim].astype(jnp.float32)
    rot = jnp.concatenate([-xr[..., half:], xr[..., :half]], axis=-1)
    out = (xr * cos + rot * sin).astype(x.dtype)
    return jnp.concatenate([out, x[..., rot_dim:]], axis=-1)


def retention_scan(q, k, v, log_gamma):
    b, h, s, _ = q.shape
    dk, dv = q.shape[-1], v.shape[-1]
    c = RET_CHUNK
    n_chunks = s // c
    idx = jnp.arange(c, dtype=jnp.float32)
    rel = idx[:, None] - idx[None, :]
    lg = log_gamma[:, None, None]
    d_intra = jnp.where(rel >= 0, jnp.exp(jnp.maximum(rel, 0.0) * lg), 0.0)
    xi = jnp.exp((idx[None, :] + 1.0) * log_gamma[:, None])[:, :, None]
    zeta = jnp.exp((c - 1.0 - idx[None, :]) * log_gamma[:, None])[:, :, None]
    chunk_decay = jnp.exp(c * log_gamma)[:, None, None]

    def to_chunks(t):
        return t.reshape(b, h, n_chunks, c, t.shape[-1]).transpose(2, 0, 1, 3, 4)

    def step(state, inp):
        qc, kc, vc = inp
        qf, kf, vf = qc.astype(jnp.float32), kc.astype(jnp.float32), vc.astype(jnp.float32)
        scores = jnp.einsum('bhnd,bhmd->bhnm', qf, kf) * d_intra
        o = jnp.einsum('bhnm,bhme->bhne', scores, vf) + jnp.einsum('bhnd,bhde->bhne', qf * xi, state)
        state = chunk_decay * state + jnp.einsum('bhmd,bhme->bhde', kf * zeta, vf)
        return state, o

    state0 = jnp.zeros((b, h, dk, dv), jnp.float32)
    _, o = lax.scan(step, state0, (to_chunks(q), to_chunks(k), to_chunks(v)))
    return o.transpose(1, 2, 0, 3, 4).reshape(b, h, s, dv)


def diff_attention(q, k, v, lam):
    b, h2, s, dq = q.shape
    h = h2 // 2
    n_blocks = s // Q_BLOCK
    scale = dq ** -0.5
    qb = q.reshape(b, h2, n_blocks, Q_BLOCK, dq).transpose(2, 0, 1, 3, 4)

    def block(q_blk):
        sc = jnp.einsum('bhqd,bhkd->bhqk', q_blk, k).astype(jnp.float32) * scale
        a = jax.nn.softmax(sc, axis=-1).reshape(b, h, 2, Q_BLOCK, s)
        a = a[:, :, 0] - lam * a[:, :, 1]
        return jnp.einsum('bhqk,bhkd->bhqd', a.astype(v.dtype), v)

    o = lax.map(block, qb)
    return o.transpose(1, 2, 0, 3, 4).reshape(b, h, s, v.shape[-1])


def encoder_layer(x, w_in, dec_f, dec_b, ret_gn_w, lq1, lk1, lq2, lk2, subln_w, w_out,
                  ln1_g, ln1_b, w_gate, w_up, w_down, ln2_g, ln2_b, lambda_init):
    b, s, _ = x.shape
    pos = jnp.arange(s, dtype=jnp.float32)
    proj = x @ w_in
    splits = [RQ_COLS, RQ_COLS + RK_COLS, RQ_COLS + RK_COLS + RV_COLS,
              RQ_COLS + RK_COLS + RV_COLS + RG_COLS,
              RQ_COLS + RK_COLS + RV_COLS + RG_COLS + DQ_COLS,
              RQ_COLS + RK_COLS + RV_COLS + RG_COLS + DQ_COLS + DK_COLS]
    rq, rk, rv, rg, dq, dk, dv = jnp.split(proj, splits, axis=-1)

    def heads(t, n):
        return t.reshape(b, s, n, -1).transpose(0, 2, 1, 3)

    rq = apply_rope(heads(rq, RET_HEADS), pos, RET_QK_DIM, RET_ROT_BASE)
    rk = apply_rope(heads(rk, RET_HEADS), pos, RET_QK_DIM, RET_ROT_BASE) * (RET_QK_DIM ** -0.5)
    rv = heads(rv, RET_HEADS)
    lg_f = -jnp.exp(dec_f.astype(jnp.float32))
    lg_b = -jnp.exp(dec_b.astype(jnp.float32))
    flip = lambda t: jnp.flip(t, axis=2)
    ro = retention_scan(rq, rk, rv, lg_f) + flip(retention_scan(flip(rq), flip(rk), flip(rv), lg_b))
    mu = jnp.mean(ro, axis=-1, keepdims=True)
    var = jnp.mean(jnp.square(ro - mu), axis=-1, keepdims=True)
    ro = (ro - mu) * lax.rsqrt(var + GN_EPS)
    ro = ro.transpose(0, 2, 1, 3).reshape(b, s, RV_COLS) * ret_gn_w.astype(jnp.float32)
    ro = (jax.nn.silu(rg.astype(jnp.float32)) * ro).astype(x.dtype)

    dq = apply_rope(heads(dq, 2 * DIFF_HEADS), pos, DIFF_ROT_DIM, ROPE_THETA)
    dk = apply_rope(heads(dk, 2 * DIFF_HEADS), pos, DIFF_ROT_DIM, ROPE_THETA)
    dv = heads(dv, DIFF_HEADS)
    lam = (jnp.exp(jnp.sum(lq1.astype(jnp.float32) * lk1.astype(jnp.float32)))
           - jnp.exp(jnp.sum(lq2.astype(jnp.float32) * lk2.astype(jnp.float32))) + lambda_init)
    do = diff_attention(dq, dk, dv, lam).astype(jnp.float32)
    do = do * lax.rsqrt(jnp.mean(jnp.square(do), axis=-1, keepdims=True) + RMS_EPS)
    do = do * subln_w.astype(jnp.float32) * (1.0 - lambda_init)
    do = do.transpose(0, 2, 1, 3).reshape(b, s, DV_COLS).astype(x.dtype)

    mix = jnp.concatenate([ro, do], axis=-1) @ w_out
    x = layer_norm(DEEPNORM_ALPHA * x + mix, ln1_g, ln1_b)
    ffn = (jax.nn.silu(x @ w_gate) * (x @ w_up)) @ w_down
    return layer_norm(DEEPNORM_ALPHA * x + ffn, ln2_g, ln2_b)


def setup_inputs(seed: int = 0) -> dict:
    key = jax.random.key(seed)
    ks = jax.random.split(key, 20)
    f32 = jnp.float32
    nrm = lambda k, shape: jax.random.normal(k, shape, f32)
    x_prompt = nrm(ks[0], (BATCH, SEQ, D_MODEL))
    x_sample = nrm(ks[1], (DEC_BATCH, DEC_SEQ, D_MODEL))
    col_scale = np.ones((IN_COLS,), np.float32)
    v_r0 = RQ_COLS + RK_COLS
    col_scale[v_r0:v_r0 + RV_COLS] = DEEPNORM_BETA
    col_scale[IN_COLS - DV_COLS:] = DEEPNORM_BETA
    w_in = nrm(ks[2], (DEPTH, D_MODEL, IN_COLS)) * (D_MODEL ** -0.5) * jnp.asarray(col_scale)
    base_decay = np.log(-np.log(1.0 - 2.0 ** (-5.0 - np.arange(RET_HEADS)))).astype(np.float32)
    ret_decay_f = jnp.asarray(base_decay)[None, :] + 0.05 * nrm(ks[3], (DEPTH, RET_HEADS))
    ret_decay_b = jnp.asarray(base_decay)[None, :] + 0.05 * nrm(ks[4], (DEPTH, RET_HEADS))
    ret_gn_w = 1.0 + 0.02 * nrm(ks[5], (DEPTH, RV_COLS))
    diff_lambda_q1 = 0.1 * nrm(ks[6], (DEPTH, DIFF_QK_DIM))
    diff_lambda_k1 = 0.1 * nrm(ks[7], (DEPTH, DIFF_QK_DIM))
    diff_lambda_q2 = 0.1 * nrm(ks[8], (DEPTH, DIFF_QK_DIM))
    diff_lambda_k2 = 0.1 * nrm(ks[9], (DEPTH, DIFF_QK_DIM))
    diff_subln_w = 1.0 + 0.02 * nrm(ks[10], (DEPTH, DIFF_V_DIM))
    w_out = nrm(ks[11], (DEPTH, MIX_WIDTH, D_MODEL)) * (MIX_WIDTH ** -0.5) * DEEPNORM_BETA
    ln1_g = 1.0 + 0.02 * nrm(ks[12], (DEPTH, D_MODEL))
    ln1_b = 0.02 * nrm(ks[13], (DEPTH, D_MODEL))
    w_gate = nrm(ks[14], (DEPTH, D_MODEL, D_FF)) * (D_MODEL ** -0.5)
    w_up = nrm(ks[15], (DEPTH, D_MODEL, D_FF)) * (D_MODEL ** -0.5) * DEEPNORM_BETA
    w_down = nrm(ks[16], (DEPTH, D_FF, D_MODEL)) * (D_FF ** -0.5) * DEEPNORM_BETA
    ln2_g = 1.0 + 0.02 * nrm(ks[17], (DEPTH, D_MODEL))
    ln2_b = 0.02 * nrm(ks[18], (DEPTH, D_MODEL))
    return {'x_prompt': x_prompt, 'x_sample': x_sample, 'w_in': w_in,
            'ret_decay_f': ret_decay_f, 'ret_decay_b': ret_decay_b, 'ret_gn_w': ret_gn_w,
            'diff_lambda_q1': diff_lambda_q1, 'diff_lambda_k1': diff_lambda_k1,
            'diff_lambda_q2': diff_lambda_q2, 'diff_lambda_k2': diff_lambda_k2,
            'diff_subln_w': diff_subln_w, 'w_out': w_out, 'ln1_g': ln1_g, 'ln1_b': ln1_b,
            'w_gate': w_gate, 'w_up': w_up, 'w_down': w_down, 'ln2_g': ln2_g, 'ln2_b': ln2_b}


def reference(x_prompt, x_sample, w_in, ret_decay_f, ret_decay_b, ret_gn_w,
              diff_lambda_q1, diff_lambda_k1, diff_lambda_q2, diff_lambda_k2, diff_subln_w,
              w_out, ln1_g, ln1_b, w_gate, w_up, w_down, ln2_g, ln2_b):
    y_prompt = x_prompt
    y_sample = x_sample
    for l in range(DEPTH):
        lambda_init = 0.8 - 0.6 * math.exp(-0.3 * l)
        params = (w_in[l], ret_decay_f[l], ret_decay_b[l], ret_gn_w[l],
                  diff_lambda_q1[l], diff_lambda_k1[l], diff_lambda_q2[l], diff_lambda_k2[l],
                  diff_subln_w[l], w_out[l], ln1_g[l], ln1_b[l],
                  w_gate[l], w_up[l], w_down[l], ln2_g[l], ln2_b[l])
        y_prompt = encoder_layer(y_prompt, *params, lambda_init)
        y_sample = encoder_layer(y_sample, *params, lambda_init)
    return (y_prompt, y_sample)
```

```cpp
#include <hip/hip_runtime.h>
#include <hip/hip_bf16.h>
#include <cstdio>
#include <cstdint>

namespace pg8 {
#define PG8_LAS __attribute__((address_space(3)))
typedef unsigned short bf16_t;
typedef short bf16x8 __attribute__((ext_vector_type(8)));
typedef float f32x4 __attribute__((ext_vector_type(4)));
typedef int i32x4 __attribute__((ext_vector_type(4)));
typedef int i32x8 __attribute__((ext_vector_type(8)));
typedef unsigned u32x4 __attribute__((ext_vector_type(4)));
constexpr int BM = 256, BK = 64, HALF = 128, HTB = HALF * BK * 2, STAGE_BYTES = 8 * HTB, NXCD = 8, WGM = 8;

__host__ __device__ __forceinline__ int lds_byte(int r, int c) { const int st = (r >> 4) * 2 + (c >> 5), rr = r & 15, cc = c & 31, ob = rr * 64 + cc * 2; return st * 1024 + (ob ^ (((ob >> 9) & 1) << 5)); }
__host__ __device__ __forceinline__ void stage_rc(int b, int& R, int& C) { const int st = b / 1024, sb = b % 1024, swz = sb ^ (((sb >> 9) & 1) << 5); R = (st >> 1) * 16 + swz / 64; C = (st & 1) * 32 + (swz % 64) / 2; }
__host__ __device__ __forceinline__ int perm32(int rho) { const int n = rho >> 4, i = rho & 15; return 8 * (i >> 2) + 4 * n + (i & 3); }

struct Unit { int pm, pn; };
struct Gemm { const bf16_t* A; const bf16_t* Bt; int M, N, K; };

struct StaticOrder {
    int nM, nN, nwg, G, c;
    __host__ __device__ void init(int M, int N, int G_, int c_) { nM = M / BM; nN = N / BM; nwg = nM * nN; G = G_; c = c_; }
    __host__ __device__ bool next(int i, Unit& u) const {
        const long L = (long)i * G + c; if (L >= nwg) return false;
        int wgid = (int)L; { const int q = nwg / NXCD, r = nwg % NXCD, xcd = wgid % NXCD, off = wgid / NXCD; wgid = (xcd < r ? xcd * (q + 1) : r * (q + 1) + (xcd - r) * q) + off; }
        const int nig = WGM * nN, gid = wgid / nig, fm = gid * WGM, gsz = (nM - fm) < WGM ? (nM - fm) : WGM;
        u.pm = fm + ((wgid % nig) % gsz); u.pn = (wgid % nig) / gsz; return true;
    }
    __device__ __forceinline__ void a_ready(const Unit&) const {}
    __device__ __forceinline__ void done(const Unit&) const {}
};

__device__ __forceinline__ unsigned cvt_pk_bf16(float lo, float hi) { unsigned r; asm volatile("v_cvt_pk_bf16_f32 %0, %1, %2" : "=v"(r) : "v"(lo), "v"(hi)); return r; }

struct EpiBf16 {
    static constexpr bool PERM = true, AFTER_DRAIN = false;
    bf16_t* O; int ldc;
    __device__ __forceinline__ void operator()(const f32x4 (&acc)[2][2][4][2], const Unit& u, int wr, int wc, int fr, int fq) const {
        const int row0 = u.pm * BM + wr * 64 + fr; const int col0 = u.pn * BM + wc * 32 + 8 * fq;
#pragma unroll
        for (int ai = 0; ai < 2; ++ai)
#pragma unroll
            for (int m = 0; m < 4; ++m) { bf16_t* rowp = O + (size_t)(row0 + ai * HALF + m * 16) * ldc + col0;
#pragma unroll
                for (int bj = 0; bj < 2; ++bj) { const f32x4 v0 = acc[ai][bj][m][0], v1 = acc[ai][bj][m][1];
                    u32x4 w; w.x = cvt_pk_bf16(v0[0], v0[1]); w.y = cvt_pk_bf16(v0[2], v0[3]); w.z = cvt_pk_bf16(v1[0], v1[1]); w.w = cvt_pk_bf16(v1[2], v1[3]);
                    *(u32x4*)(rowp + bj * HALF) = w; } }
    }
};
struct EpiBf16NP {
    static constexpr bool PERM = false, AFTER_DRAIN = false;
    bf16_t* O; int ldc;
    __device__ __forceinline__ void operator()(const f32x4 (&acc)[2][2][4][2], const Unit& u, int wr, int wc, int fr, int fq) const {
        typedef unsigned u32x2 __attribute__((ext_vector_type(2)));
        const int row0 = u.pm * BM + wr * 64 + fr; const int col0 = u.pn * BM + wc * 32 + 4 * fq;
#pragma unroll
        for (int ai = 0; ai < 2; ++ai)
#pragma unroll
            for (int m = 0; m < 4; ++m) { bf16_t* rowp = O + (size_t)(row0 + ai * HALF + m * 16) * ldc + col0;
#pragma unroll
                for (int bj = 0; bj < 2; ++bj)
#pragma unroll
                    for (int n = 0; n < 2; ++n) { const f32x4 v = acc[ai][bj][m][n]; u32x2 w; w.x = cvt_pk_bf16(v[0], v[1]); w.y = cvt_pk_bf16(v[2], v[3]);
                        *(u32x2*)(rowp + bj * HALF + n * 16) = w; } }
    }
};
struct EpiProj {
    static constexpr bool PERM = true, AFTER_DRAIN = false;
    bf16_t* O; int ldc; const float* tabR; const float* tabD; int seqmask;
    __device__ __forceinline__ void operator()(const f32x4 (&acc)[2][2][4][2], const Unit& u, int wr, int wc, int fr, int fq) const {
        typedef float f32x8 __attribute__((ext_vector_type(8)));
        const int row0 = u.pm * BM + wr * 64 + fr; const int col0 = u.pn * BM + wc * 32 + 8 * fq;
        const int pn = u.pn;
        const bool ret = pn < 8, dif = pn >= 24 && pn < 40;
        const float sc = (pn >= 4 && pn < 8) ? 0.088388347648318440f : ((pn >= 24 && pn < 32) ? 0.088388347648318440f * 1.4426950408889634f : 1.0f);
        const bool rot = ret || (dif && wc == 0);
        f32x8 csa[2][4];
#pragma unroll
        for (int ai = 0; ai < 2; ++ai)
#pragma unroll
            for (int m = 0; m < 4; ++m) { const int row = row0 + ai * HALF + m * 16; csa[ai][m] = (f32x8){1.f, 0.f, 1.f, 0.f, 1.f, 0.f, 1.f, 0.f};
                if (rot) { const int pos = row & seqmask; csa[ai][m] = ret ? *(const f32x8*)(tabR + ((size_t)pos * 64 + 4 * (4 * wc + fq)) * 2) : *(const f32x8*)(tabD + ((size_t)pos * 16 + 4 * fq) * 2); } }
#pragma unroll
        for (int ai = 0; ai < 2; ++ai)
#pragma unroll
            for (int m = 0; m < 4; ++m) { const int row = row0 + ai * HALF + m * 16; bf16_t* rowp = O + (size_t)row * ldc + col0;
                const f32x8 cs = csa[ai][m];
#pragma unroll
                for (int bj = 0; bj < 2; ++bj) { const f32x4 v0 = acc[ai][bj][m][0], v1 = acc[ai][bj][m][1]; f32x4 o0, o1;
#pragma unroll
                    for (int k = 0; k < 4; ++k) { o0[k] = (v0[k] * cs[2 * k] - v1[k] * cs[2 * k + 1]) * sc; o1[k] = (v1[k] * cs[2 * k] + v0[k] * cs[2 * k + 1]) * sc; }
                    u32x4 w; w.x = cvt_pk_bf16(o0[0], o0[1]); w.y = cvt_pk_bf16(o0[2], o0[3]); w.z = cvt_pk_bf16(o1[0], o1[1]); w.w = cvt_pk_bf16(o1[2], o1[3]);
                    *(u32x4*)(rowp + bj * HALF) = w; } }
    }
};
__device__ __forceinline__ float silu_f(float x) { return x * __builtin_amdgcn_rcpf(1.0f + __builtin_amdgcn_exp2f(-1.4426950408889634f * x)); }
constexpr int H16 = 5376, H8 = 5632, HROWB = 16384, KT16 = H16 / 64;
static_assert(H16 * 2 + H8 == HROWB && H16 % 128 == 0 && H8 % 256 == 0 && (KT16 % 2) == 0, "mixed hidden row");
template <bool Q> struct EpiSwiGLUT {
    static constexpr bool PERM = true, AFTER_DRAIN = false;
    bf16_t* O; int ldc; const float* SA; const float* CM;
    static __device__ __forceinline__ f32x4 deq(const f32x4 a, const float sa, const f32x4 cm) { if constexpr (!Q) return a; else { const i32x4 i = __builtin_bit_cast(i32x4, a); return (f32x4){(float)i[0] * (sa * cm[0]), (float)i[1] * (sa * cm[1]), (float)i[2] * (sa * cm[2]), (float)i[3] * (sa * cm[3])}; } }
    __device__ __forceinline__ void operator()(const f32x4 (&acc)[2][2][4][2], const Unit& u, int wr, int wc, int fr, int fq) const {
        const int row0 = u.pm * BM + wr * 64 + fr; const int col0 = u.pn * HALF + wc * 32 + 8 * fq;
        f32x4 cg0 = {1.f, 1.f, 1.f, 1.f}, cg1 = cg0, cu0 = cg0, cu1 = cg0;
        if constexpr (Q) { cg0 = *(const f32x4*)(CM + col0); cg1 = *(const f32x4*)(CM + col0 + 4); cu0 = *(const f32x4*)(CM + ldc + col0); cu1 = *(const f32x4*)(CM + ldc + col0 + 4); }
        if (u.pn * HALF >= H16) {
#pragma unroll
            for (int ai = 0; ai < 2; ++ai)
#pragma unroll
                for (int m = 0; m < 4; ++m) { unsigned char* rowp = (unsigned char*)O + (size_t)(row0 + ai * HALF + m * 16) * HROWB + H16 * 2 + (col0 - H16);
                    float sa = 1.f; if constexpr (Q) sa = SA[row0 + ai * HALF + m * 16];
                    const f32x4 g0 = deq(acc[ai][0][m][0], sa, cg0), g1 = deq(acc[ai][0][m][1], sa, cg1), u0 = deq(acc[ai][1][m][0], sa, cu0), u1 = deq(acc[ai][1][m][1], sa, cu1);
                    float v[8];
#pragma unroll
                    for (int j = 0; j < 4; ++j) { v[j] = __builtin_amdgcn_fmed3f(silu_f(g0[j]) * u0[j] * 4.0f, -448.f, 448.f); v[4 + j] = __builtin_amdgcn_fmed3f(silu_f(g1[j]) * u1[j] * 4.0f, -448.f, 448.f); }
                    int w0 = __builtin_amdgcn_cvt_pk_fp8_f32(v[0], v[1], 0, false); w0 = __builtin_amdgcn_cvt_pk_fp8_f32(v[2], v[3], w0, true);
                    int w1 = __builtin_amdgcn_cvt_pk_fp8_f32(v[4], v[5], 0, false); w1 = __builtin_amdgcn_cvt_pk_fp8_f32(v[6], v[7], w1, true);
                    typedef int i32x2 __attribute__((ext_vector_type(2)));
                    *(i32x2*)rowp = (i32x2){w0, w1}; }
            return; }
#pragma unroll
        for (int ai = 0; ai < 2; ++ai)
#pragma unroll
            for (int m = 0; m < 4; ++m) { bf16_t* rowp = (bf16_t*)((unsigned char*)O + (size_t)(row0 + ai * HALF + m * 16) * HROWB) + col0;
                float sa = 1.f; if constexpr (Q) sa = SA[row0 + ai * HALF + m * 16];
                    const f32x4 g0 = deq(acc[ai][0][m][0], sa, cg0), g1 = deq(acc[ai][0][m][1], sa, cg1), u0 = deq(acc[ai][1][m][0], sa, cu0), u1 = deq(acc[ai][1][m][1], sa, cu1);
                f32x4 v0, v1;
#pragma unroll
                for (int j = 0; j < 4; ++j) { v0[j] = silu_f(g0[j]) * u0[j]; v1[j] = silu_f(g1[j]) * u1[j]; }
                u32x4 w; w.x = cvt_pk_bf16(v0[0], v0[1]); w.y = cvt_pk_bf16(v0[2], v0[3]); w.z = cvt_pk_bf16(v1[0], v1[1]); w.w = cvt_pk_bf16(v1[2], v1[3]);
                *(u32x4*)rowp = w; }
    }
};
typedef EpiSwiGLUT<false> EpiSwiGLU; typedef EpiSwiGLUT<true> EpiSwiGLUQ;
constexpr int F8_SC_W = 0x78787878, F8_SC_H = 0x7d7d7d7d;
__device__ __forceinline__ i32x8 cat8(bf16x8 lo, bf16x8 hi) { const i32x4 a = __builtin_bit_cast(i32x4, lo), b = __builtin_bit_cast(i32x4, hi); return __builtin_shufflevector(a, b, 0, 1, 2, 3, 4, 5, 6, 7); }
__device__ __forceinline__ void glds_saddr(unsigned voff, const void* sbase, unsigned lds_dst) { unsigned keep;
    asm volatile("s_mov_b32 %0, m0\n\ts_mov_b32 m0, %3\n\ts_nop 0\n\tglobal_load_lds_dwordx4 %1, %2\n\ts_mov_b32 m0, %0" : "=&s"(keep) : "v"(voff), "s"(sbase), "s"(lds_dst) : "memory"); }
template <class Epi, class Sched, bool ALIGN_EPI = false, bool SP2 = false, int KS8 = 0, bool I8 = false>
__device__ __forceinline__ void gemm_phase(PG8_LAS unsigned char* lds, const Gemm g, const Sched& S, const Epi& E, int tid) {
    asm volatile("" : "+v"(tid));
    const int wid = __builtin_amdgcn_readfirstlane(tid >> 6), lane = tid & 63, wr = wid >> 2, wc = wid & 3, fr = lane & 15, fq = lane >> 4;
    const int K = g.K, nt = K / BK;
    unsigned voffA[2], voffB[2];
#pragma unroll
    for (int i = 0; i < 2; ++i) { int R, C; stage_rc(tid * 16 + i * 8192, R, C); const int Rb = Epi::PERM ? ((R & ~31) + perm32(R & 31)) : R;
        voffA[i] = (unsigned)(R * K + C) * 2u; voffB[i] = (unsigned)(Rb * K + C) * 2u; }
    const size_t kstep = (size_t)(BK * 2);
    const size_t hstep = (size_t)HALF * K * 2;
    const size_t tstep = 2 * hstep;
    const unsigned ldsw = (unsigned)wid * 1024u;
    const int aoff = lds_byte(wr * 64 + fr, fq * 8), boff = lds_byte(wc * 32 + fr, fq * 8);
#define PG8_SA(b, h) (((b) * 2 + (h)) * HTB)
#define PG8_SB(b, h) ((4 + (b) * 2 + (h)) * HTB)
#define PG8_STAGE(bufoff, gbase, voff) do { _Pragma("unroll") for (int _i = 0; _i < 2; ++_i) { \
        if constexpr (KS8 > 0) glds_saddr((voff)[_i], (const void*)(gbase), (unsigned)__builtin_amdgcn_readfirstlane((int)(unsigned)(size_t)(lds + (bufoff) + ldsw + _i * 8192))); \
        else __builtin_amdgcn_global_load_lds((const unsigned*)((const char*)(gbase) + (voff)[_i]), (PG8_LAS unsigned*)(lds + (bufoff) + ldsw + _i * 8192), 16, 0, 0); } } while (0)
#define PG8_LDA(dst, b, h) do { _Pragma("unroll") for (int m = 0; m < 4; ++m) _Pragma("unroll") for (int k = 0; k < 2; ++k) dst[m][k] = *(const PG8_LAS bf16x8*)(lds + PG8_SA(b, h) + aoff + m * 2048 + k * 1024); } while (0)
#define PG8_LDB(dst, b, h) do { _Pragma("unroll") for (int n = 0; n < 2; ++n) _Pragma("unroll") for (int k = 0; k < 2; ++k) dst[n][k] = *(const PG8_LAS bf16x8*)(lds + PG8_SB(b, h) + boff + n * 2048 + k * 1024); } while (0)
#define PG8_MMA(ai, bj, At, Bt) do { __builtin_amdgcn_s_setprio(1); _Pragma("unroll") for (int m = 0; m < 4; ++m) _Pragma("unroll") for (int n = 0; n < 2; ++n) _Pragma("unroll") for (int k = 0; k < 2; ++k) \
        acc[ai][bj][m][n] = __builtin_amdgcn_mfma_f32_16x16x32_bf16(Bt[n][k], At[m][k], acc[ai][bj][m][n], 0, 0, 0); __builtin_amdgcn_s_setprio(0); } while (0)
#define PG8_MMA8(ai, bj, At, Bt) do { __builtin_amdgcn_s_setprio(1); _Pragma("unroll") for (int m = 0; m < 4; ++m) _Pragma("unroll") for (int n = 0; n < 2; ++n) \
        acc[ai][bj][m][n] = __builtin_amdgcn_mfma_scale_f32_16x16x128_f8f6f4(cat8(Bt[n][0], Bt[n][1]), cat8(At[m][0], At[m][1]), acc[ai][bj][m][n], 0, 0, 0, F8_SC_W, 0, F8_SC_H); __builtin_amdgcn_s_setprio(0); } while (0)
#define PG8_MMAI(ai, bj, At, Bt) do { __builtin_amdgcn_s_setprio(1); _Pragma("unroll") for (int m = 0; m < 4; ++m) _Pragma("unroll") for (int n = 0; n < 2; ++n) _Pragma("unroll") for (int k = 0; k < 2; ++k) \
        acc[ai][bj][m][n] = __builtin_bit_cast(f32x4, __builtin_amdgcn_mfma_i32_16x16x64_i8(__builtin_bit_cast(i32x4, Bt[n][k]), __builtin_bit_cast(i32x4, At[m][k]), __builtin_bit_cast(i32x4, acc[ai][bj][m][n]), 0, 0, 0)); __builtin_amdgcn_s_setprio(0); } while (0)
#define PG8_WAIT_V(n) asm volatile("s_waitcnt vmcnt(" #n ")" ::: "memory")
#define PG8_WAIT_L(n) asm volatile("s_waitcnt lgkmcnt(" #n ")" ::: "memory")
#define PG8_BAR __builtin_amdgcn_s_barrier()
#define PG8_SCHED __builtin_amdgcn_sched_barrier(0)
    Unit cur, nxt; int ui = 0;
    if (!S.next(0, cur)) return;
    f32x4 acc[2][2][4][2];
#pragma unroll
    for (int a = 0; a < 2; ++a)
#pragma unroll
        for (int b = 0; b < 2; ++b)
#pragma unroll
            for (int m = 0; m < 4; ++m)
#pragma unroll
                for (int n = 0; n < 2; ++n) acc[a][b][m][n] = (f32x4){0.f, 0.f, 0.f, 0.f};
    bf16x8 At[4][2], B0[2][2], B1[2][2];
    const char* cA = (const char*)g.A + (size_t)cur.pm * tstep; const char* cB = (const char*)g.Bt + (size_t)cur.pn * tstep;
    S.a_ready(cur);
    if constexpr (SP2) {
        PG8_STAGE(PG8_SB(0, 0), cB, voffB); PG8_STAGE(PG8_SB(0, 1), cB + hstep, voffB); PG8_STAGE(PG8_SA(0, 0), cA, voffA); PG8_STAGE(PG8_SA(0, 1), cA + hstep, voffA);
        if (wr == 1) PG8_BAR;
        PG8_WAIT_V(2); PG8_BAR;
        PG8_STAGE(PG8_SB(1, 0), cB + kstep, voffB); PG8_STAGE(PG8_SA(1, 0), cA + kstep, voffA); PG8_STAGE(PG8_SB(1, 1), cB + hstep + kstep, voffB);
        PG8_WAIT_V(6); PG8_BAR;
    } else {
        PG8_STAGE(PG8_SB(0, 0), cB, voffB); PG8_STAGE(PG8_SA(0, 0), cA, voffA); PG8_STAGE(PG8_SB(0, 1), cB + hstep, voffB); PG8_STAGE(PG8_SA(0, 1), cA + hstep, voffA);
        if (wr == 1) PG8_BAR;
        PG8_WAIT_V(4); PG8_BAR;
        PG8_STAGE(PG8_SB(1, 0), cB + kstep, voffB); PG8_STAGE(PG8_SA(1, 0), cA + kstep, voffA); PG8_STAGE(PG8_SB(1, 1), cB + hstep + kstep, voffB);
        PG8_WAIT_V(6); PG8_BAR;
    }
    for (;;) {
        const bool has_next = S.next(ui + 1, nxt);
        const char* nA = has_next ? (const char*)g.A + (size_t)nxt.pm * tstep : cA; const char* nB = has_next ? (const char*)g.Bt + (size_t)nxt.pn * tstep : cB;
#define PG8_ITER_HEAD() \
            const bool last = (t == nt - 2); \
            const char* a1 = cA + (size_t)(t + 1) * kstep; \
            const char* a2 = last ? nA : cA + (size_t)(t + 2) * kstep; const char* b2 = last ? nB : cB + (size_t)(t + 2) * kstep; \
            const char* a3 = a2 + kstep; const char* b3 = b2 + kstep; \
            if (last && has_next) S.a_ready(nxt);
#define PG8_ITER_SP2(MM) \
            PG8_LDB(B0, 0, 0); PG8_LDB(B1, 0, 1); PG8_SCHED; PG8_LDA(At, 0, 0); PG8_STAGE(PG8_SA(1, 1), a1 + hstep, voffA); \
            PG8_WAIT_V(8); PG8_WAIT_L(0); PG8_BAR; MM(0, 0, At, B0); MM(0, 1, At, B1); PG8_BAR; PG8_SCHED; \
            PG8_LDA(At, 0, 1); PG8_STAGE(PG8_SB(0, 0), b2, voffB); PG8_STAGE(PG8_SB(0, 1), b2 + hstep, voffB); PG8_STAGE(PG8_SA(0, 0), a2, voffA); \
            PG8_WAIT_V(8); PG8_WAIT_L(0); PG8_BAR; MM(1, 0, At, B0); MM(1, 1, At, B1); PG8_BAR; PG8_SCHED; \
            PG8_LDB(B0, 1, 0); PG8_LDB(B1, 1, 1); PG8_SCHED; PG8_LDA(At, 1, 0); PG8_STAGE(PG8_SA(0, 1), a2 + hstep, voffA); \
            PG8_WAIT_V(8); PG8_WAIT_L(0); PG8_BAR; MM(0, 0, At, B0); MM(0, 1, At, B1); PG8_BAR; PG8_SCHED; \
            PG8_LDA(At, 1, 1); PG8_STAGE(PG8_SB(1, 0), b3, voffB); PG8_STAGE(PG8_SB(1, 1), b3 + hstep, voffB); PG8_STAGE(PG8_SA(1, 0), a3, voffA); \
            PG8_WAIT_V(8); PG8_WAIT_L(0); PG8_BAR; MM(1, 0, At, B0); MM(1, 1, At, B1); PG8_BAR; PG8_SCHED;
        int t = 0;
        if constexpr (SP2 && I8) {
            for (; t < nt; t += 2) { PG8_ITER_HEAD() PG8_ITER_SP2(PG8_MMAI) }
        } else if constexpr (SP2 && KS8 > 0) {
            for (; t < KS8; t += 2) { PG8_ITER_HEAD() PG8_ITER_SP2(PG8_MMA) }
            for (; t < nt; t += 2) { PG8_ITER_HEAD() PG8_ITER_SP2(PG8_MMA8) }
        } else {
        for (; t < nt; t += 2) {
            PG8_ITER_HEAD()
            if constexpr (SP2) {
            PG8_ITER_SP2(PG8_MMA)
            } else {
            PG8_LDB(B0, 0, 0); PG8_SCHED; PG8_LDA(At, 0, 0); PG8_STAGE(PG8_SA(1, 1), a1 + hstep, voffA);
            PG8_WAIT_L(8); PG8_BAR; PG8_WAIT_L(0); PG8_MMA(0, 0, At, B0); PG8_BAR; PG8_SCHED;
            PG8_LDB(B1, 0, 1); PG8_STAGE(PG8_SB(0, 0), b2, voffB);
            PG8_BAR; PG8_WAIT_L(0); PG8_MMA(0, 1, At, B1); PG8_BAR;
            PG8_LDA(At, 0, 1); PG8_STAGE(PG8_SA(0, 0), a2, voffA);
            PG8_BAR; PG8_WAIT_L(0); PG8_MMA(1, 0, At, B0); PG8_BAR; PG8_SCHED;
            PG8_STAGE(PG8_SB(0, 1), b2 + hstep, voffB);
            PG8_WAIT_V(6); PG8_BAR; PG8_MMA(1, 1, At, B1); PG8_BAR;
            PG8_LDB(B0, 1, 0); PG8_SCHED; PG8_LDA(At, 1, 0); PG8_STAGE(PG8_SA(0, 1), a2 + hstep, voffA);
            PG8_WAIT_L(8); PG8_BAR; PG8_WAIT_L(0); PG8_MMA(0, 0, At, B0); PG8_BAR; PG8_SCHED;
            PG8_LDB(B1, 1, 1); PG8_STAGE(PG8_SB(1, 0), b3, voffB);
            PG8_BAR; PG8_WAIT_L(0); PG8_MMA(0, 1, At, B1); PG8_BAR;
            PG8_LDA(At, 1, 1); PG8_STAGE(PG8_SA(1, 0), a3, voffA);
            PG8_BAR; PG8_WAIT_L(0); PG8_MMA(1, 0, At, B0); PG8_BAR; PG8_SCHED;
            PG8_STAGE(PG8_SB(1, 1), b3 + hstep, voffB);
            PG8_WAIT_V(6); PG8_BAR; PG8_MMA(1, 1, At, B1); PG8_BAR;
            }
        }
        }
        if constexpr (ALIGN_EPI) { if (wr == 0) PG8_BAR; }
        if constexpr (!Epi::AFTER_DRAIN) { int l2; asm volatile("v_mbcnt_lo_u32_b32 %0, -1, 0\n\tv_mbcnt_hi_u32_b32 %0, -1, %0" : "=v"(l2));
            E(acc, cur, wr, wc, l2 & 15, l2 >> 4); S.done(cur); }
        if (!has_next) break;
#pragma unroll
        for (int a = 0; a < 2; ++a)
#pragma unroll
            for (int b = 0; b < 2; ++b)
#pragma unroll
                for (int m = 0; m < 4; ++m)
#pragma unroll
                    for (int n = 0; n < 2; ++n) acc[a][b][m][n] = (f32x4){0.f, 0.f, 0.f, 0.f};
        cur = nxt; cA = nA; cB = nB; ++ui;
        if constexpr (ALIGN_EPI) { if (wr == 1) PG8_BAR; }
    }
    PG8_WAIT_V(0);
    if constexpr (!ALIGN_EPI) { if (wr == 0) PG8_BAR; }
    PG8_BAR;
#undef PG8_SA
#undef PG8_SB
#undef PG8_STAGE
#undef PG8_LDA
#undef PG8_LDB
#undef PG8_MMA
#undef PG8_MMA8
#undef PG8_MMAI
#undef PG8_ITER_HEAD
#undef PG8_ITER_SP2
#undef PG8_WAIT_V
#undef PG8_WAIT_L
#undef PG8_BAR
#undef PG8_SCHED
}
}

constexpr int DM = 4096, TOK = 16384, INC = 12288, DFF = 11008, NGU = 2 * DFF;
constexpr int LDP = INC;
constexpr int C_RQ = 0, C_RK = 1024, C_RV = 2048, C_RG = 4096, C_DQ = 6144, C_DK = 8192, C_DV = 10240;
constexpr float LN_EPS = 1e-5f, GN_EPS = 1e-6f, RMS_EPS = 1e-5f;
constexpr float DEEP_ALPHA = 1.189207115002721f;
constexpr float LAMBDA_INIT = 0.2f;

namespace att {
using hbf = __hip_bfloat16;
constexpr int D = 128, NW = 8, QBLK = 32, KVBLK = 64;
constexpr float SCALE = 0.088388347648318440f;
constexpr float QSCALE = SCALE * 1.4426950408889634f;
constexpr float THR = 8.f;
constexpr int SDEPTH = 2;
constexpr int LDQ = LDP, LDK = LDP, LDO = 2048;
constexpr size_t SHM_V = KVBLK * D * 2, SHM_K = KVBLK * D * 2, SHM_ATTN = 2 * SHM_V + 2 * SHM_K + NW * 64 * 4;
using bf16x8 = __attribute__((ext_vector_type(8))) short;
using s16x4  = __attribute__((ext_vector_type(4))) short;
using f32x16 = __attribute__((ext_vector_type(16))) float;
using u32x4  = __attribute__((ext_vector_type(4))) unsigned;
#define KSWZ(row, colB) ((row) * 256 + ((colB) ^ (((row) & 7) << 4)))
#define SBAR() __builtin_amdgcn_sched_barrier(0)
__device__ __forceinline__ int crow(int r, int hi) { return (r & 3) + 8 * (r >> 2) + 4 * hi; }
__device__ __forceinline__ unsigned cvtpk(float lo, float hi) { unsigned r; asm volatile("v_cvt_pk_bf16_f32 %0, %1, %2" : "=v"(r) : "v"(lo), "v"(hi)); return r; }

#define PK4(P, BASE, OUT) do { unsigned a0 = cvtpk(P[BASE + 0], P[BASE + 1]), a1 = cvtpk(P[BASE + 2], P[BASE + 3]);   \
    unsigned b0 = cvtpk(P[BASE + 4], P[BASE + 5]), b1 = cvtpk(P[BASE + 6], P[BASE + 7]);                              \
    auto r0 = __builtin_amdgcn_permlane32_swap(a0, b0, false, false); auto r1 = __builtin_amdgcn_permlane32_swap(a1, b1, false, false); \
    u32x4 w = {r0[0], r1[0], r0[1], r1[1]}; OUT = *reinterpret_cast<bf16x8*>(&w); } while (0)
__device__ __forceinline__ void qkt(f32x16& p0, f32x16& p1, const hbf* Ks, const bf16x8* qr, int r32, int hi) {
  p0 = f32x16{}; p1 = f32x16{};
#pragma unroll
  for (int d0 = 0; d0 < 8; ++d0) { int cb = (d0 * 16 + hi * 8) * 2;
    bf16x8 b0 = *reinterpret_cast<const bf16x8*>((const char*)Ks + KSWZ(r32, cb));
    bf16x8 b1 = *reinterpret_cast<const bf16x8*>((const char*)Ks + KSWZ(32 + r32, cb));
    p0 = __builtin_amdgcn_mfma_f32_32x32x16_bf16(b0, qr[d0], p0, 0, 0, 0);
    p1 = __builtin_amdgcn_mfma_f32_32x32x16_bf16(b1, qr[d0], p1, 0, 0, 0); }
}
__device__ __forceinline__ int v_st(int k, int c) { const int kk = (k & ~0xC) | ((k & 4) << 1) | ((k & 8) >> 1); return ((kk >> 3) * 4 + (c >> 5)) * 512 + ((kk & 7) * 32 + (c & 31)) * 2; }
__device__ __forceinline__ int v_rd_base(int lane) { return ((lane & 3) << 3) | (((lane >> 2) & 3) << 6) | (((lane >> 4) & 1) << 5) | (((lane >> 5) & 1) << 8); }
constexpr int v_rd_off(int d0, int ks, int half) { return d0 * 512 + ks * 4096 + half * 2048; }
template <int OFF> __device__ __forceinline__ s16x4 tr_read(int vb) {
  s16x4 r; asm volatile("ds_read_b64_tr_b16 %0, %1 offset:%2" : "=&v"(r) : "v"(vb), "i"(OFF) : "memory"); return r;
}
#define PKLH(L, H) (bf16x8){L[0], L[1], L[2], L[3], H[0], H[1], H[2], H[3]}
template <int D0> __device__ __forceinline__ void pv_one(f32x16& od, int vb, bf16x8 pa0, bf16x8 pa1, bf16x8 pa2, bf16x8 pa3) {
  const s16x4 l0 = tr_read<v_rd_off(D0, 0, 0)>(vb), h0 = tr_read<v_rd_off(D0, 0, 1)>(vb), l1 = tr_read<v_rd_off(D0, 1, 0)>(vb), h1 = tr_read<v_rd_off(D0, 1, 1)>(vb);
  const s16x4 l2 = tr_read<v_rd_off(D0, 2, 0)>(vb), h2 = tr_read<v_rd_off(D0, 2, 1)>(vb), l3 = tr_read<v_rd_off(D0, 3, 0)>(vb), h3 = tr_read<v_rd_off(D0, 3, 1)>(vb);
  asm volatile("s_waitcnt lgkmcnt(0)" ::: "memory"); SBAR();
  od = __builtin_amdgcn_mfma_f32_32x32x16_bf16(pa0, PKLH(l0, h0), od, 0, 0, 0);
  od = __builtin_amdgcn_mfma_f32_32x32x16_bf16(pa1, PKLH(l1, h1), od, 0, 0, 0);
  od = __builtin_amdgcn_mfma_f32_32x32x16_bf16(pa2, PKLH(l2, h2), od, 0, 0, 0);
  od = __builtin_amdgcn_mfma_f32_32x32x16_bf16(pa3, PKLH(l3, h3), od, 0, 0, 0);
}
__device__ __forceinline__ void pv_d0(f32x16* o, int vb, bf16x8 pa0, bf16x8 pa1, bf16x8 pa2, bf16x8 pa3) {
  pv_one<0>(o[0], vb, pa0, pa1, pa2, pa3); pv_one<1>(o[1], vb, pa0, pa1, pa2, pa3); pv_one<2>(o[2], vb, pa0, pa1, pa2, pa3); pv_one<3>(o[3], vb, pa0, pa1, pa2, pa3);
}

constexpr float THR2 = 11.5f;
__device__ __forceinline__ float softmax_rel(f32x16& p0, f32x16& p1, bool first, float& m_reg, float& l_reg, bf16x8& pa0, bf16x8& pa1, bf16x8& pa2, bf16x8& pa3) {
  float pmax = p0[0];
#pragma unroll
  for (int r = 1; r < 16; ++r) pmax = fmaxf(pmax, p0[r]);
#pragma unroll
  for (int r = 0; r < 16; ++r) pmax = fmaxf(pmax, p1[r]);
  { auto rr = __builtin_amdgcn_permlane32_swap(__float_as_uint(pmax), __float_as_uint(pmax), false, false);
    pmax = fmaxf(__uint_as_float(rr[0]), __uint_as_float(rr[1])); }
  float alpha = 1.f;
  if (__builtin_expect(first || __any(pmax > THR2), 0)) {
    const float dl = first ? pmax : fmaxf(pmax, 0.f);
    m_reg += dl; alpha = first ? 1.f : __builtin_amdgcn_exp2f(-dl);
#pragma unroll
    for (int r = 0; r < 16; ++r) { p0[r] -= dl; p1[r] -= dl; }
  }
#pragma unroll
  for (int r = 0; r < 16; ++r) p0[r] = __builtin_amdgcn_exp2f(p0[r]);
#pragma unroll
  for (int r = 0; r < 16; ++r) p1[r] = __builtin_amdgcn_exp2f(p1[r]);
  float ps = 0;
#pragma unroll
  for (int r = 0; r < 16; ++r) ps += p0[r];
#pragma unroll
  for (int r = 0; r < 16; ++r) ps += p1[r];
  { auto rr = __builtin_amdgcn_permlane32_swap(__float_as_uint(ps), __float_as_uint(ps), false, false);
    ps = __uint_as_float(rr[0]) + __uint_as_float(rr[1]); }
  l_reg = l_reg * alpha + ps;
  PK4(p0, 0, pa0); PK4(p0, 8, pa1); PK4(p1, 0, pa2); PK4(p1, 8, pa3);
  return alpha;
}
template <int OFF> __device__ __forceinline__ bf16x8 lds_rd128(int addr) { bf16x8 r; asm volatile("ds_read_b128 %0, %1 offset:%2" : "=&v"(r) : "v"(addr), "i"(OFF) : "memory"); return r; }
__device__ __forceinline__ void qkt_pipe(f32x16& p0, f32x16& p1, int kbt, int kc, const bf16x8* qr, const f32x16& z) {
  bf16x8 a0, b0, a1, b1, a2, b2, a3, b3;
#define KRD(A, B, d0) do { const int ad_ = (kc ^ ((d0) << 5)) + kbt; A = lds_rd128<0>(ad_); B = lds_rd128<8192>(ad_); } while (0)
#define KW(N) do { asm volatile("s_waitcnt lgkmcnt(" #N ")" ::: "memory"); SBAR(); } while (0)
  KRD(a0, b0, 0); KRD(a1, b1, 1); KRD(a2, b2, 2); KRD(a3, b3, 3);
  KW(6); p0 = __builtin_amdgcn_mfma_f32_32x32x16_bf16(a0, qr[0], z, 0, 0, 0);  p1 = __builtin_amdgcn_mfma_f32_32x32x16_bf16(b0, qr[0], z, 0, 0, 0);  SBAR(); KRD(a0, b0, 4);
  KW(6); p0 = __builtin_amdgcn_mfma_f32_32x32x16_bf16(a1, qr[1], p0, 0, 0, 0); p1 = __builtin_amdgcn_mfma_f32_32x32x16_bf16(b1, qr[1], p1, 0, 0, 0); SBAR(); KRD(a1, b1, 5);
  KW(6); p0 = __builtin_amdgcn_mfma_f32_32x32x16_bf16(a2, qr[2], p0, 0, 0, 0); p1 = __builtin_amdgcn_mfma_f32_32x32x16_bf16(b2, qr[2], p1, 0, 0, 0); SBAR(); KRD(a2, b2, 6);
  KW(6); p0 = __builtin_amdgcn_mfma_f32_32x32x16_bf16(a3, qr[3], p0, 0, 0, 0); p1 = __builtin_amdgcn_mfma_f32_32x32x16_bf16(b3, qr[3], p1, 0, 0, 0); SBAR(); KRD(a3, b3, 7);
  KW(6); p0 = __builtin_amdgcn_mfma_f32_32x32x16_bf16(a0, qr[4], p0, 0, 0, 0); p1 = __builtin_amdgcn_mfma_f32_32x32x16_bf16(b0, qr[4], p1, 0, 0, 0); SBAR();
  KW(4); p0 = __builtin_amdgcn_mfma_f32_32x32x16_bf16(a1, qr[5], p0, 0, 0, 0); p1 = __builtin_amdgcn_mfma_f32_32x32x16_bf16(b1, qr[5], p1, 0, 0, 0); SBAR();
  KW(2); p0 = __builtin_amdgcn_mfma_f32_32x32x16_bf16(a2, qr[6], p0, 0, 0, 0); p1 = __builtin_amdgcn_mfma_f32_32x32x16_bf16(b2, qr[6], p1, 0, 0, 0); SBAR();
  KW(0); p0 = __builtin_amdgcn_mfma_f32_32x32x16_bf16(a3, qr[7], p0, 0, 0, 0); p1 = __builtin_amdgcn_mfma_f32_32x32x16_bf16(b3, qr[7], p1, 0, 0, 0);
#undef KRD
#undef KW
}
struct VFrag { s16x4 l0, h0, l1, h1, l2, h2, l3, h3; };
template <int D0> __device__ __forceinline__ void vf_read(VFrag& f, int vb) {
  f.l0 = tr_read<v_rd_off(D0, 0, 0)>(vb); f.h0 = tr_read<v_rd_off(D0, 0, 1)>(vb); f.l1 = tr_read<v_rd_off(D0, 1, 0)>(vb); f.h1 = tr_read<v_rd_off(D0, 1, 1)>(vb);
  f.l2 = tr_read<v_rd_off(D0, 2, 0)>(vb); f.h2 = tr_read<v_rd_off(D0, 2, 1)>(vb); f.l3 = tr_read<v_rd_off(D0, 3, 0)>(vb); f.h3 = tr_read<v_rd_off(D0, 3, 1)>(vb);
}
__device__ __forceinline__ void vf_mma(f32x16& od, const VFrag& f, bf16x8 pa0, bf16x8 pa1, bf16x8 pa2, bf16x8 pa3) {
  od = __builtin_amdgcn_mfma_f32_32x32x16_bf16(pa0, PKLH(f.l0, f.h0), od, 0, 0, 0);
  od = __builtin_amdgcn_mfma_f32_32x32x16_bf16(pa1, PKLH(f.l1, f.h1), od, 0, 0, 0);
  od = __builtin_amdgcn_mfma_f32_32x32x16_bf16(pa2, PKLH(f.l2, f.h2), od, 0, 0, 0);
  od = __builtin_amdgcn_mfma_f32_32x32x16_bf16(pa3, PKLH(f.l3, f.h3), od, 0, 0, 0);
}
#define VF_WAIT(N) do { asm volatile("s_waitcnt lgkmcnt(" #N ")" ::: "memory"); SBAR(); } while (0)
__device__ __forceinline__ void pv8(f32x16* o, int vb, bf16x8 pa0, bf16x8 pa1, bf16x8 pa2, bf16x8 pa3) {
  VFrag fa, fb; const int vb2 = vb + 16384;
  vf_read<0>(fa, vb);
  vf_read<1>(fb, vb);  VF_WAIT(8); vf_mma(o[0], fa, pa0, pa1, pa2, pa3); SBAR();
  vf_read<2>(fa, vb);  VF_WAIT(8); vf_mma(o[1], fb, pa0, pa1, pa2, pa3); SBAR();
  vf_read<3>(fb, vb);  VF_WAIT(8); vf_mma(o[2], fa, pa0, pa1, pa2, pa3); SBAR();
  vf_read<0>(fa, vb2); VF_WAIT(8); vf_mma(o[3], fb, pa0, pa1, pa2, pa3); SBAR();
  vf_read<1>(fb, vb2); VF_WAIT(8); vf_mma(o[4], fa, pa0, pa1, pa2, pa3); SBAR();
  vf_read<2>(fa, vb2); VF_WAIT(8); vf_mma(o[5], fb, pa0, pa1, pa2, pa3); SBAR();
  vf_read<3>(fb, vb2); VF_WAIT(8); vf_mma(o[6], fa, pa0, pa1, pa2, pa3); SBAR();
  VF_WAIT(0); vf_mma(o[7], fb, pa0, pa1, pa2, pa3);
}

constexpr int A_LDS_K = 0, A_LDS_V = 49152, A_LDS_WS = 147456;
constexpr long TSTRIDE = 64L * LDP * 2;
__device__ __forceinline__ void glds16(const void* gsrc, unsigned lds_dst) { unsigned keep;
  asm volatile("s_mov_b32 %0, m0\n\ts_mov_b32 m0, %2\n\ts_nop 0\n\tglobal_load_lds_dwordx4 %1, off ; A256DMA\n\ts_mov_b32 m0, %0" : "=&s"(keep) : "v"(gsrc), "s"(lds_dst) : "memory"); }
#define A_WAITBAR(N) asm volatile("s_waitcnt vmcnt(" #N ") lgkmcnt(0) ; A256BAR\n\ts_barrier" ::: "memory")
template <int mode>
__device__ __forceinline__ void attn256_unit(const hbf* __restrict__ Qb, const hbf* __restrict__ Kh, const hbf* __restrict__ Vh, int seq, char* lds, int tid,
                                             float* stash, unsigned short* mixo, float lam, const float* __restrict__ sublnw) {
  asm volatile("" : "+v"(tid));
  const int wid = __builtin_amdgcn_readfirstlane(tid >> 6), lane = tid & 63, r32 = lane & 31, hi = lane >> 5;
  const unsigned lds0 = (unsigned)(uintptr_t)lds;
  float* ws = (float*)(lds + A_LDS_WS) + wid * 64; float* li_l = ws; float* al_l = ws + 32;
  unsigned koff[2], voff[4];
#pragma unroll
  for (int i = 0; i < 2; ++i) { const int row = (wid * 2 + i) * 4 + (lane >> 4), chunk = (lane & 15) ^ (((row & 7) << 1) | ((row >> 3) & 1)); koff[i] = (unsigned)(row * (LDP * 2) + chunk * 16); }
#pragma unroll
  for (int i = 0; i < 4; ++i) { const int q = (wid & 3) * 4 + i, subtile = q * 2 + (lane >> 5), kk = (subtile >> 2) * 8 + ((lane & 31) >> 2);
    const int k = (kk & ~0xC) | ((kk & 4) << 1) | ((kk & 8) >> 1), col = (subtile & 3) * 32 + (lane & 3) * 8;
    voff[i] = (unsigned)(k * (LDP * 2) + ((wid >> 2) * 128 + col) * 2); }
  const char* Kb = (const char*)Kh; const char* Vb = (const char*)Vh;
  const unsigned kdst = lds0 + A_LDS_K + wid * 2048, vdst = lds0 + A_LDS_V + (wid >> 2) * 16384 + (wid & 3) * 4096;
#define RFL(x) ((unsigned)__builtin_amdgcn_readfirstlane((int)(x)))
#define DMA_K(t, sl) do { const char* b_ = Kb + (size_t)(t) * TSTRIDE; const unsigned d_ = RFL(kdst + (sl) * 16384); glds16(b_ + koff[0], d_); glds16(b_ + koff[1], d_ + 1024); } while (0)
#define DMA_V(t, sl) do { const char* b_ = Vb + (size_t)(t) * TSTRIDE; const unsigned d_ = RFL(vdst + (sl) * 32768); glds16(b_ + voff[0], d_); glds16(b_ + voff[1], d_ + 1024); glds16(b_ + voff[2], d_ + 2048); glds16(b_ + voff[3], d_ + 3072); } while (0)
  bf16x8 qr[8];
  { const hbf* Qw = Qb + (long)(wid * QBLK + r32) * LDQ + hi * 8;
#pragma unroll
    for (int d0 = 0; d0 < 8; ++d0) qr[d0] = *reinterpret_cast<const bf16x8*>(Qw + d0 * 16); }
  asm volatile("" : "+v"(qr[0]), "+v"(qr[1]), "+v"(qr[2]), "+v"(qr[3]), "+v"(qr[4]), "+v"(qr[5]), "+v"(qr[6]), "+v"(qr[7]));
  DMA_K(0, 0); DMA_V(0, 0); DMA_K(1, 1); DMA_V(1, 1);
  float m_reg = 0.f, l_reg = 0; f32x16 o[8] = {};
  const int vb0 = (int)(lds0 + A_LDS_V) + v_rd_base(lane);
  const int kb0 = (int)(lds0 + A_LDS_K) + r32 * 256, kc = (hi << 4) ^ ((((r32 & 7) << 1) | ((r32 >> 3) & 1)) << 4);
  const int NT = seq / KVBLK;
#define RESC(a) do { if (__any((a) < 1.f)) { if (hi == 0) al_l[r32] = (a); asm volatile("s_waitcnt lgkmcnt(0)" ::: "memory"); \
    _Pragma("unroll") for (int d = 0; d < 8; ++d) _Pragma("unroll") for (int r = 0; r < 16; ++r) o[d][r] *= al_l[crow(r, hi)]; } } while (0)
  A_WAITBAR(6);
  if (wid >= 4) asm volatile("s_barrier" ::: "memory");
  int s0 = 0, s1 = 1, s2 = 2;
  for (int j = 0; j < NT; ++j) {
    const bool more = j + 2 < NT;
    if (more) DMA_K(j + 2, s2);
    f32x16 p0, p1; bf16x8 pa0, pa1, pa2, pa3;
    __builtin_amdgcn_s_setprio(2);
    { f32x16 negm;
#pragma unroll
      for (int r = 0; r < 16; ++r) negm[r] = -m_reg;
      qkt_pipe(p0, p1, kb0 + s0 * 16384, kc, qr, negm); }
    const float alpha = softmax_rel(p0, p1, j == 0, m_reg, l_reg, pa0, pa1, pa2, pa3);
    RESC(alpha);
    __builtin_amdgcn_s_setprio(0);
    if (more) A_WAITBAR(6); else A_WAITBAR(0);
    if (more) DMA_V(j + 2, s2);
    pv8(o, vb0 + s0 * 32768, pa0, pa1, pa2, pa3);
    if (more) A_WAITBAR(6); else A_WAITBAR(0);
    { const int t_ = s0; s0 = s1; s1 = s2; s2 = t_; }
  }
  if (wid < 4) asm volatile("s_barrier" ::: "memory");
  if (hi == 0) li_l[r32] = l_reg; asm volatile("s_waitcnt lgkmcnt(0)" ::: "memory");
  float rli[16];
#pragma unroll
  for (int r = 0; r < 16; ++r) rli[r] = __builtin_amdgcn_rcpf(li_l[crow(r, hi)]);
  typedef float f32x4_t __attribute__((ext_vector_type(4)));
  f32x4_t* st4 = (f32x4_t*)stash + (size_t)wid * 2048 + lane;
  if constexpr (mode == 0) {
#pragma unroll
    for (int d0 = 0; d0 < 8; ++d0)
#pragma unroll
      for (int q = 0; q < 4; ++q) st4[(d0 * 4 + q) * 64] = (f32x4_t){o[d0][4 * q] * rli[4 * q], o[d0][4 * q + 1] * rli[4 * q + 1], o[d0][4 * q + 2] * rli[4 * q + 2], o[d0][4 * q + 3] * rli[4 * q + 3]};
  } else {
    typedef __attribute__((address_space(3))) float lds_f32;
    lds_f32* rs = (lds_f32*)(lds0 + A_LDS_WS + wid * 256 + 128);
    if (hi == 0) rs[r32] = 0.f;
    float ss[16];
#pragma unroll
    for (int r = 0; r < 16; ++r) ss[r] = 0.f;
#pragma unroll
    for (int d0 = 0; d0 < 8; ++d0) {
      f32x4_t a0, a1, a2, a3;
      { typedef unsigned long long u64; const u64* p0 = (const u64*)&st4[(d0 * 4 + 0) * 64]; const u64* p1 = (const u64*)&st4[(d0 * 4 + 1) * 64]; const u64* p2 = (const u64*)&st4[(d0 * 4 + 2) * 64]; const u64* p3 = (const u64*)&st4[(d0 * 4 + 3) * 64];
        const u64 x0 = __hip_atomic_load(p0, __ATOMIC_RELAXED, __HIP_MEMORY_SCOPE_AGENT), x1 = __hip_atomic_load(p0 + 1, __ATOMIC_RELAXED, __HIP_MEMORY_SCOPE_AGENT);
        const u64 y0 = __hip_atomic_load(p1, __ATOMIC_RELAXED, __HIP_MEMORY_SCOPE_AGENT), y1 = __hip_atomic_load(p1 + 1, __ATOMIC_RELAXED, __HIP_MEMORY_SCOPE_AGENT);
        const u64 z0 = __hip_atomic_load(p2, __ATOMIC_RELAXED, __HIP_MEMORY_SCOPE_AGENT), z1 = __hip_atomic_load(p2 + 1, __ATOMIC_RELAXED, __HIP_MEMORY_SCOPE_AGENT);
        const u64 w0 = __hip_atomic_load(p3, __ATOMIC_RELAXED, __HIP_MEMORY_SCOPE_AGENT), w1 = __hip_atomic_load(p3 + 1, __ATOMIC_RELAXED, __HIP_MEMORY_SCOPE_AGENT);
        a0 = (f32x4_t){__uint_as_float((unsigned)x0), __uint_as_float((unsigned)(x0 >> 32)), __uint_as_float((unsigned)x1), __uint_as_float((unsigned)(x1 >> 32))};
        a1 = (f32x4_t){__uint_as_float((unsigned)y0), __uint_as_float((unsigned)(y0 >> 32)), __uint_as_float((unsigned)y1), __uint_as_float((unsigned)(y1 >> 32))};
        a2 = (f32x4_t){__uint_as_float((unsigned)z0), __uint_as_float((unsigned)(z0 >> 32)), __uint_as_float((unsigned)z1), __uint_as_float((unsigned)(z1 >> 32))};
        a3 = (f32x4_t){__uint_as_float((unsigned)w0), __uint_as_float((unsigned)(w0 >> 32)), __uint_as_float((unsigned)w1), __uint_as_float((unsigned)(w1 >> 32))}; }
#pragma unroll
      for (int k = 0; k < 4; ++k) {
        float d;
        d = a0[k] - lam * (o[d0][k] * rli[k]);           o[d0][k] = d;      ss[k] += d * d;
        d = a1[k] - lam * (o[d0][4 + k] * rli[4 + k]);   o[d0][4 + k] = d;  ss[4 + k] += d * d;
        d = a2[k] - lam * (o[d0][8 + k] * rli[8 + k]);   o[d0][8 + k] = d;  ss[8 + k] += d * d;
        d = a3[k] - lam * (o[d0][12 + k] * rli[12 + k]); o[d0][12 + k] = d; ss[12 + k] += d * d; }
      asm volatile("" : "+v"(o[d0]) :: "memory");
    }
    asm volatile("s_waitcnt lgkmcnt(0)" ::: "memory");
#pragma unroll
    for (int r = 0; r < 16; ++r) __hip_atomic_fetch_add(rs + crow(r, hi), ss[r], __ATOMIC_RELAXED, __HIP_MEMORY_SCOPE_WORKGROUP);
    asm volatile("s_waitcnt lgkmcnt(0)" ::: "memory");
#pragma unroll
    for (int r = 0; r < 16; ++r) ss[r] = (1.0f - LAMBDA_INIT) / sqrtf(rs[crow(r, hi)] * (1.0f / 256.0f) + RMS_EPS);
    unsigned short* stg = (unsigned short*)(lds + wid * 16384);
#pragma unroll
    for (int d0 = 0; d0 < 8; ++d0) { const float sw = sublnw[d0 * 32 + r32];
#pragma unroll
      for (int r = 0; r < 16; ++r) stg[crow(r, hi) * 256 + d0 * 32 + r32] = (unsigned short)(cvtpk(o[d0][r] * ss[r] * sw, 0.f) & 0xffffu); }
    asm volatile("s_waitcnt lgkmcnt(0)" ::: "memory");
    unsigned short* Mw = mixo + (size_t)(wid * QBLK) * DM;
#pragma unroll
    for (int i = 0; i < 16; ++i) { const int p = i * 64 + lane, row = p >> 5, ch = p & 31;
      const u32x4 v = *(const u32x4*)(stg + row * 256 + ch * 8); *(u32x4*)(Mw + (size_t)row * DM + ch * 8) = v; }
    asm volatile("s_waitcnt lgkmcnt(0)\n\ts_barrier" ::: "memory");
  }
#undef RESC
#undef DMA_K
#undef DMA_V
#undef RFL
}
}

constexpr int NWAVES = 8;
constexpr size_t MiB = 1u << 20;
constexpr size_t WS_CTL = 0, CTL_ZERO_BYTES = 1 * MiB;
constexpr size_t WS_PAR = 1 * MiB;
constexpr int PAR_DECF = 0, PAR_DECB = 8, PAR_LQ1 = 16, PAR_LK1 = 144, PAR_LQ2 = 272, PAR_LK2 = 400, PAR_SUBLN = 528, PAR_GNW = 784, PAR_LN1G = 2832, PAR_LN1B = 6928, PAR_LN2G = 11024, PAR_LN2B = 15120, PAR_LAM = 19216, PAR_END = 19232;
constexpr size_t WS_TABR = 2 * MiB;
constexpr size_t WS_TABD = 10 * MiB;
constexpr size_t WS_WIN = 12 * MiB;
constexpr size_t WS_WOUT = 108 * MiB;
constexpr size_t WS_WGU = 140 * MiB;
constexpr size_t WS_XQ = 228 * MiB;
constexpr size_t WS_SA = 292 * MiB;
constexpr size_t WS_WD = 312 * MiB;
constexpr size_t WS_XB = 398 * MiB;
constexpr size_t WS_PROJ = 526 * MiB;
constexpr size_t WS_OS = 910 * MiB;
constexpr size_t WS_END = 1166 * MiB;
static_assert(WS_WIN + (size_t)INC * DM * 2 <= WS_WOUT && WS_WOUT + (size_t)DM * DM * 2 <= WS_WGU && WS_WGU + (size_t)NGU * DM * 2 <= WS_WD && WS_WD + (size_t)DM * DFF * 2 <= WS_XB, "ws map");
static_assert(WS_XB + (size_t)TOK * DM * 2 <= WS_PROJ && WS_PROJ + (size_t)TOK * INC * 2 <= WS_OS && WS_OS + (size_t)2 * TOK * 2048 * 4 <= WS_END, "ws map");
constexpr int CW_BAR = 4096;
constexpr int CW_CMAX = 32768;
static_assert(WS_WGU + (size_t)NGU * DM <= WS_XQ && WS_XQ + (size_t)TOK * DM <= WS_SA && WS_SA + (size_t)TOK * 4 <= WS_WD && (CW_CMAX + 2 * DFF) * 4 <= (int)CTL_ZERO_BYTES, "ws map (int8 operands)");
constexpr int RING_BYTES = 131072;
constexpr int LDSCTL_OFF = 147456 + 2048, MISC_OFF = LDSCTL_OFF + 320;
constexpr int LDS_BYTES = 163840;

#define LAS __attribute__((address_space(3)))
typedef unsigned short bf16;
typedef unsigned v4u __attribute__((ext_vector_type(4)));
typedef unsigned v2u __attribute__((ext_vector_type(2)));
typedef float f32x4 __attribute__((ext_vector_type(4)));
typedef int i32x4 __attribute__((ext_vector_type(4)));
typedef int i32x8 __attribute__((ext_vector_type(8)));
typedef float f32x2 __attribute__((ext_vector_type(2)));
#define LDS_WAIT() asm volatile("s_waitcnt lgkmcnt(0)" ::: "memory")
__device__ __forceinline__ unsigned f2bf(float f) { unsigned u = __builtin_bit_cast(unsigned, f); return (u + 0x7fffu + ((u >> 16) & 1u)) >> 16; }
__device__ __forceinline__ unsigned pk2(float lo, float hi) { return f2bf(lo) | (f2bf(hi) << 16); }
__device__ __forceinline__ float bflo(unsigned w) { return __uint_as_float(w << 16); }
__device__ __forceinline__ float bfhi(unsigned w) { return __uint_as_float(w & 0xffff0000u); }

#define XB_TMO      128
#define XB_XCNT(j)  (256  + 64 * (j))
#define XB_XSUB(j)  (1280 + 64 * (j))
#define XB_XGEN(j)  (2304 + 64 * (j))
#define XB_TOP      3328
#define XB_TOPGEN   3392
#define XCD_BAR_WORDS 3456
#define XB_SPIN_CAP (1u << 18)
__device__ __forceinline__ unsigned xb_ld(unsigned* p)              { asm volatile("" : "+v"(p)); return __hip_atomic_load(p, __ATOMIC_RELAXED, __HIP_MEMORY_SCOPE_AGENT); }
__device__ __forceinline__ unsigned xb_add(unsigned* p, unsigned v) { asm volatile("" : "+v"(p)); return __hip_atomic_fetch_add(p, v, __ATOMIC_RELAXED, __HIP_MEMORY_SCOPE_AGENT); }
__device__ __forceinline__ unsigned xb_xcc_id() { return (unsigned)__builtin_amdgcn_s_getreg((3 << 11) | 20) & 0xFu; }
#define XB_SPIN(cond, bar) do { unsigned _sp = 0; while (cond) { __builtin_amdgcn_s_sleep(1); \
    if ((++_sp & 255u) == 0u) { if (xb_ld(&(bar)[XB_TMO])) break; if (_sp > XB_SPIN_CAP) { (void)xb_add(&(bar)[XB_TMO], 1u); break; } } } } while (0)
struct XcdBarrier { unsigned* bar; unsigned x; volatile LAS unsigned* st; };
__device__ __forceinline__ XcdBarrier xcd_barrier_post(unsigned* bar, volatile LAS unsigned* st, int tid) {
    XcdBarrier b; b.bar = bar; b.x = xb_xcc_id(); b.st = st;
    if (tid == 0) (void)xb_add(&bar[XB_XCNT(b.x)], 1u);
    return b;
}
__device__ __forceinline__ void xcd_barrier_complete(unsigned* bar, unsigned x, unsigned& nloc, unsigned& nx) {
    const unsigned G = gridDim.x * gridDim.y * gridDim.z;
    unsigned sum, cnt, mine, sp = 0u;
    for (;;) {
        sum = 0u; cnt = 0u; mine = 0u;
#pragma unroll
        for (unsigned j = 0; j < 16; ++j) { const unsigned c = xb_ld(&bar[XB_XCNT(j)]); sum += c; cnt += (c > 0u) ? 1u : 0u; mine = (j == x) ? c : mine; }
        if (sum == G) break;
        __builtin_amdgcn_s_sleep(1);
        if ((++sp & 255u) == 0u) { if (xb_ld(&bar[XB_TMO])) break; if (sp > XB_SPIN_CAP) { (void)xb_add(&bar[XB_TMO], 1u); break; } }
    }
    nloc = mine > 0u ? mine : 1u; nx = cnt > 0u ? cnt : 1u;
}
__device__ __forceinline__ void xcd_barrier(const XcdBarrier& b, int tid) {
    asm volatile("s_waitcnt vmcnt(0)" ::: "memory");
    __syncthreads();
    if (tid == 0) {
        unsigned* bar = b.bar;
        __builtin_amdgcn_s_waitcnt(0);
        unsigned nloc = b.st[0], nx = b.st[1];
        if (nloc == 0u) { xcd_barrier_complete(bar, b.x, nloc, nx); b.st[0] = nloc; b.st[1] = nx; }
        const unsigned old = xb_add(&bar[XB_XSUB(b.x)], 1u);
        const unsigned gen = old / nloc;
        if (old + 1u == (gen + 1u) * nloc) {
            __builtin_amdgcn_fence(__ATOMIC_RELEASE, "agent");
            asm volatile("s_waitcnt vmcnt(0)" ::: "memory");
            const unsigned og = xb_add(&bar[XB_TOP], 1u);
            const unsigned tg = og / nx;
            if (og + 1u == (tg + 1u) * nx) xb_add(&bar[XB_TOPGEN], 1u);
            else XB_SPIN(xb_ld(&bar[XB_TOPGEN]) == tg, bar);
            __builtin_amdgcn_fence(__ATOMIC_ACQUIRE, "agent");
            xb_add(&bar[XB_XGEN(b.x)], 1u);
            asm volatile("s_waitcnt vmcnt(0)" ::: "memory");
        } else {
            XB_SPIN(xb_ld(&bar[XB_XGEN(b.x)]) == gen, bar);
            __builtin_amdgcn_fence(__ATOMIC_ACQUIRE, "agent");
            asm volatile("s_waitcnt vmcnt(0)" ::: "memory");
        }
    }
    __syncthreads();
}

__device__ __forceinline__ float wave_sum(float v, int lane) {
#pragma unroll
    for (int o = 1; o < 64; o <<= 1) v += __int_as_float(__builtin_amdgcn_ds_bpermute((lane ^ o) << 2, __float_as_int(v)));
    return v;
}

__device__ __forceinline__ float wave_max(float v, int lane) {
#pragma unroll
    for (int o = 1; o < 64; o <<= 1) v = fmaxf(v, __int_as_float(__builtin_amdgcn_ds_bpermute((lane ^ o) << 2, __float_as_int(v))));
    return v;
}
__device__ __forceinline__ unsigned pk_i8x4(float a, float b, float c, float d) {
    const unsigned u0 = __float_as_uint(a + 12582912.f), u1 = __float_as_uint(b + 12582912.f), u2 = __float_as_uint(c + 12582912.f), u3 = __float_as_uint(d + 12582912.f);
    return (u0 & 255u) | ((u1 & 255u) << 8) | ((u2 & 255u) << 16) | (u3 << 24);
}

__host__ __device__ __forceinline__ int rowmap_in(int n) {
    if (n < 2048) { const int d = n & 127; const int p = (d < 64) ? (8 * (d >> 2) + (d & 3)) : (8 * ((d - 64) >> 2) + 4 + (d & 3)); return (n & ~127) + p; }
    if (n >= 6144 && n < 10240) { const int d = n & 127; if (d < 32) { const int p = (d < 16) ? (8 * (d >> 2) + (d & 3)) : (8 * ((d - 16) >> 2) + 4 + (d & 3)); return (n & ~127) + p; } }
    return n;
}
__device__ __forceinline__ void p0_transpose_item(const float* W, int K, int N, bf16* WT, int mode, LAS float* scr, int item, int lane, const unsigned* cmax = nullptr) {
    const int nblk = N / 32, kb = item / nblk, nb = item % nblk, k0 = 64 * kb, n0 = 32 * nb;
    const int rbase = (mode == 0 || mode == 3 || mode == 4) ? n0 : (n0 + (n0 >> 7) * 128 + ((mode == 2 || mode == 6) ? 128 : 0));
    float tv[32];
#pragma unroll
    for (int i = 0; i < 32; ++i) { const int kk = 2 * i + (lane >> 5); tv[i] = W[(size_t)(k0 + kk) * N + n0 + (lane & 31)]; }
#pragma unroll
    for (int i = 0; i < 32; ++i) { const int kk = 2 * i + (lane >> 5); scr[kk * 33 + (lane & 31)] = tv[i]; }
    LDS_WAIT(); asm volatile("" ::: "memory");
    const int c = lane & 7;
#pragma unroll
    for (int j = 0; j < 4; ++j) { const int n = (lane >> 3) + 8 * j; const LAS float* s = scr + (8 * c) * 33 + n;
        v4u o; o.x = pk2(s[0 * 33], s[1 * 33]); o.y = pk2(s[2 * 33], s[3 * 33]); o.z = pk2(s[4 * 33], s[5 * 33]); o.w = pk2(s[6 * 33], s[7 * 33]);
        if (mode == 4) {
            unsigned char* rowb = (unsigned char*)WT + (size_t)(n0 + n) * pg8::HROWB;
            if (k0 < pg8::H16) *(v4u*)(rowb + (size_t)(k0 + 8 * c) * 2) = o;
            else { float q[8];
#pragma unroll
                   for (int i = 0; i < 8; ++i) q[i] = __builtin_amdgcn_fmed3f(s[i * 33] * 128.f, -448.f, 448.f);
                   int w0 = __builtin_amdgcn_cvt_pk_fp8_f32(q[0], q[1], 0, false); w0 = __builtin_amdgcn_cvt_pk_fp8_f32(q[2], q[3], w0, true);
                   int w1 = __builtin_amdgcn_cvt_pk_fp8_f32(q[4], q[5], 0, false); w1 = __builtin_amdgcn_cvt_pk_fp8_f32(q[6], q[7], w1, true);
                   v2u o8; o8.x = (unsigned)w0; o8.y = (unsigned)w1; *(v2u*)(rowb + pg8::H16 * 2 + (k0 - pg8::H16) + 8 * c) = o8; }
            continue; }
        if (mode >= 5) { const float sc = 127.f / fmaxf(__uint_as_float(cmax[(mode == 6 ? N : 0) + n0 + n]), 1e-30f);
            v2u o8; o8.x = pk_i8x4(s[0 * 33] * sc, s[1 * 33] * sc, s[2 * 33] * sc, s[3 * 33] * sc); o8.y = pk_i8x4(s[4 * 33] * sc, s[5 * 33] * sc, s[6 * 33] * sc, s[7 * 33] * sc);
            *(v2u*)((unsigned char*)WT + (size_t)(rbase + n) * K + k0 + 8 * c) = o8; continue; }
        const int drow = (mode == 3) ? rowmap_in(n0 + n) : (rbase + n);
        *(v4u*)(WT + (size_t)drow * K + k0 + 8 * c) = o; }
    LDS_WAIT(); asm volatile("" ::: "memory");
}
__device__ __forceinline__ void sincos_d(double a, float& s, float& c) {
    const double q = rint(a * 0.63661977236758134308);
    double r = fma(-q, 1.57079632679489655800e+00, a); r = fma(-q, 6.12323399573676603587e-17, r);
    const double r2 = r * r;
    const double sp = r * (1.0 + r2 * (-1.0 / 6 + r2 * (1.0 / 120 + r2 * (-1.0 / 5040 + r2 * (1.0 / 362880 + r2 * (-1.0 / 39916800 + r2 * (1.0 / 6227020800.0)))))));
    const double cp = 1.0 + r2 * (-0.5 + r2 * (1.0 / 24 + r2 * (-1.0 / 720 + r2 * (1.0 / 40320 + r2 * (-1.0 / 3628800 + r2 * (1.0 / 479001600.0 + r2 * (-1.0 / 87178291200.0)))))));
    const int qi = (int)q & 3;
    double ss = (qi & 1) ? cp : sp, cc = (qi & 1) ? sp : cp;
    if (qi == 1) cc = -cc;
    if (qi == 2) { ss = -ss; cc = -cc; }
    if (qi == 3) ss = -ss;
    s = (float)ss; c = (float)cc;
}

__device__ __forceinline__ int lane_id_v() { int r; asm volatile("v_mbcnt_lo_u32_b32 %0, -1, 0\n\tv_mbcnt_hi_u32_b32 %0, -1, %0" : "=v"(r)); return r; }
struct Args { const float* in[19]; float* out; unsigned char* ws; };

__global__ void __launch_bounds__(NWAVES * 64, 2) mega_fwd(Args args) {
    extern __shared__ __attribute__((aligned(16))) unsigned char lds[];
    LAS unsigned char* L = (LAS unsigned char*)lds;
    volatile LAS unsigned* MISC = (volatile LAS unsigned*)(L + MISC_OFF);
    const int G = gridDim.x, bx = blockIdx.x;
    const int NGW = G * NWAVES; const long NGT = (long)G * 512;
    const int wave_s = __builtin_amdgcn_readfirstlane((int)threadIdx.x >> 6);
#define LANE_ID() lane_id_v()
#define CUR_TID() (wave_s * 64 + LANE_ID())
#define PHASE_IDS() int wv_ = wave_s; asm volatile("" : "+s"(wv_)); const int wave = wv_; int tid = wave * 64 + LANE_ID(); asm volatile("" : "+v"(tid)); const int lane = tid & 63; (void)lane; \
    const int gw = bx * NWAVES + wave; const long gtid = (long)bx * 512 + tid; (void)gw; (void)gtid
#define GRID_BAR() xcd_barrier(bar, CUR_TID())
    unsigned char* ws = args.ws;
    unsigned* ctl = (unsigned*)(ws + WS_CTL);
    for (int u = threadIdx.x; u < (LDS_BYTES - LDSCTL_OFF) / 4; u += NWAVES * 64) ((LAS unsigned*)(L + LDSCTL_OFF))[u] = 0u;
    __syncthreads();
    XcdBarrier bar = xcd_barrier_post(ctl + CW_BAR, MISC + 8, (int)threadIdx.x);

    const float* PAR = (const float*)(ws + WS_PAR);
    const float* dec_f = PAR + PAR_DECF; const float* dec_b = PAR + PAR_DECB; const float* gn_w = PAR + PAR_GNW;
    const float* lq1 = PAR + PAR_LQ1; const float* lk1 = PAR + PAR_LK1; const float* lq2 = PAR + PAR_LQ2; const float* lk2 = PAR + PAR_LK2;
    const float* subln_w = PAR + PAR_SUBLN; const float* ln1_g = PAR + PAR_LN1G; const float* ln1_b = PAR + PAR_LN1B; const float* ln2_g = PAR + PAR_LN2G; const float* ln2_b = PAR + PAR_LN2B;
    bf16* Win_t = (bf16*)(ws + WS_WIN); bf16* Wout_t = (bf16*)(ws + WS_WOUT); bf16* Wgu_t = (bf16*)(ws + WS_WGU); bf16* Wd_t = (bf16*)(ws + WS_WD);
    bf16* XB = (bf16*)(ws + WS_XB); bf16* PROJ = (bf16*)(ws + WS_PROJ); bf16* HB = (bf16*)(ws + WS_PROJ); float* OS = (float*)(ws + WS_OS); bf16* KVB = (bf16*)(ws + WS_OS); bf16* SB = (bf16*)(ws + WS_OS + 128 * MiB); bf16* MP = (bf16*)(ws + WS_OS);
    f32x2* tabR = (f32x2*)(ws + WS_TABR); f32x2* tabD = (f32x2*)(ws + WS_TABD);
    unsigned* XQ = (unsigned*)(ws + WS_XQ); float* SAq = (float*)(ws + WS_SA);

    {
        PHASE_IDS();
        const float* w_in = args.in[2]; const float* w_out = args.in[11]; const float* w_gate = args.in[14]; const float* w_up = args.in[15]; const float* w_down = args.in[16];
        { float* P = (float*)(ws + WS_PAR);
          if (bx == 0) {
            for (int i = tid; i < 8; i += 512) { P[PAR_DECF + i] = args.in[3][i]; P[PAR_DECB + i] = args.in[4][i]; }
            for (int i = tid; i < 128; i += 512) { P[PAR_LQ1 + i] = args.in[6][i]; P[PAR_LK1 + i] = args.in[7][i]; P[PAR_LQ2 + i] = args.in[8][i]; P[PAR_LK2 + i] = args.in[9][i]; }
            for (int i = tid; i < 256; i += 512) P[PAR_SUBLN + i] = args.in[10][i];
            for (int i = tid; i < 2048; i += 512) P[PAR_GNW + i] = args.in[5][i];
            for (int i = tid; i < 4096; i += 512) { P[PAR_LN1G + i] = args.in[12][i]; P[PAR_LN1B + i] = args.in[13][i]; P[PAR_LN2G + i] = args.in[17][i]; P[PAR_LN2B + i] = args.in[18][i]; }
            if (wave == 0) {
              float a = args.in[6][lane] * args.in[7][lane] + args.in[6][lane + 64] * args.in[7][lane + 64], b = args.in[8][lane] * args.in[9][lane] + args.in[8][lane + 64] * args.in[9][lane + 64];
              a = wave_sum(a, lane); b = wave_sum(b, lane); if (lane == 0) P[PAR_LAM] = __expf(a) - __expf(b) + LAMBDA_INIT; }
          } }
        LAS float* scr = (LAS float*)(L + wave * 16384);
        constexpr int I_IN = (DM / 64) * (INC / 32), I_OUT = (DM / 64) * (DM / 32), I_G = (DM / 64) * (DFF / 32), I_D = (DFF / 64) * (DM / 32);
        constexpr int NITEMS = I_IN + I_OUT + I_D;
        for (int it = gw; it < NITEMS; it += NGW) {
            int r = it;
            if (r < I_IN) { p0_transpose_item(w_in, DM, INC, Win_t, 3, scr, r, lane); continue; } r -= I_IN;
            if (r < I_OUT) { p0_transpose_item(w_out, DM, DM, Wout_t, 0, scr, r, lane); continue; } r -= I_OUT;
            p0_transpose_item(w_down, DFF, DM, Wd_t, 4, scr, r, lane);
        }
        for (int it = gw; it < 2 * 16 * 43; it += NGW) { const int mat = it / 688, r = it % 688, kb = r / 43, cb = r % 43;
            const float* Wp = (mat ? w_up : w_gate) + (size_t)(kb * 256) * DFF + cb * 256 + 4 * lane;
            f32x4 mx = {0.f, 0.f, 0.f, 0.f};
            for (int i0 = 0; i0 < 256; i0 += 16) { f32x4 t[16];
#pragma unroll
                for (int i = 0; i < 16; ++i) t[i] = *(const f32x4*)(Wp + (size_t)(i0 + i) * DFF);
#pragma unroll
                for (int i = 0; i < 16; ++i) { mx[0] = fmaxf(mx[0], fabsf(t[i][0])); mx[1] = fmaxf(mx[1], fabsf(t[i][1])); mx[2] = fmaxf(mx[2], fabsf(t[i][2])); mx[3] = fmaxf(mx[3], fabsf(t[i][3])); } }
            unsigned* cmp = ctl + CW_CMAX + mat * DFF + cb * 256 + 4 * lane;
#pragma unroll
            for (int c = 0; c < 4; ++c) __hip_atomic_fetch_max(cmp + c, __float_as_uint(mx[c]), __ATOMIC_RELAXED, __HIP_MEMORY_SCOPE_AGENT); }
        for (long e = gtid; e < 16384L * 64; e += NGT) { const int pos = (int)(e >> 6), i = (int)(e & 63);
            const double inv = exp(-(double)i * (9.210340371976184 / 64.0));
            float s, c; sincos_d((double)pos * inv, s, c); tabR[e] = (f32x2){c, s}; }
        for (long e = gtid; e < 16384L * 16; e += NGT) { const int pos = (int)(e >> 4), i = (int)(e & 15);
            const double inv = exp(-(double)i * (13.122363377404328 / 16.0));
            float s, c; sincos_d((double)pos * inv, s, c); tabD[e] = (f32x2){c, s}; }
    }
    GRID_BAR();
    {
        PHASE_IDS();
        const float* w_gate = args.in[14]; const float* w_up = args.in[15];
        LAS float* scr = (LAS float*)(L + wave * 16384);
        constexpr int I_G = (DM / 64) * (DFF / 32);
        for (int it = gw; it < 2 * I_G; it += NGW) {
            if (it < I_G) p0_transpose_item(w_gate, DM, DFF, Wgu_t, 5, scr, it, lane, ctl + CW_CMAX);
            else p0_transpose_item(w_up, DM, DFF, Wgu_t, 6, scr, it - I_G, lane, ctl + CW_CMAX);
        }
    }

    for (int g = 0; g < 2; ++g) {
        const float* xin = args.in[g];
        float* outg = args.out + (size_t)g * TOK * DM;
        const int NC = g == 0 ? 128 : 32;
        const int SEQ = g == 0 ? 16384 : 4096;

#ifndef NO_PH_XCVT
        if (g == 0) { PHASE_IDS();
        constexpr long N8 = (long)TOK * DM / 8; long e = gtid;
        for (; e + 3 * NGT < N8; e += 4 * NGT) {
            f32x4 a[4], b[4];
#pragma unroll
            for (int k = 0; k < 4; ++k) { const long ek = e + k * NGT; a[k] = *(const f32x4*)(xin + ek * 8); b[k] = *(const f32x4*)(xin + ek * 8 + 4); }
#pragma unroll
            for (int k = 0; k < 4; ++k) { const long ek = e + k * NGT;
                v4u o; o.x = pk2(a[k][0], a[k][1]); o.y = pk2(a[k][2], a[k][3]); o.z = pk2(b[k][0], b[k][1]); o.w = pk2(b[k][2], b[k][3]);
                *(v4u*)(XB + ek * 8) = o; } }
        for (; e < N8; e += NGT) {
            const f32x4 a = *(const f32x4*)(xin + e * 8), b = *(const f32x4*)(xin + e * 8 + 4);
            v4u o; o.x = pk2(a[0], a[1]); o.y = pk2(a[2], a[3]); o.z = pk2(b[0], b[1]); o.w = pk2(b[2], b[3]);
            *(v4u*)(XB + e * 8) = o; } }
#endif
        if (g == 0) GRID_BAR();

#ifndef NO_PH_P1
        { pg8::Gemm gm{XB, Win_t, TOK, INC, DM}; pg8::StaticOrder S; S.init(TOK, INC, G, bx);
          pg8::EpiProj E{PROJ, INC, (const float*)tabR, (const float*)tabD, SEQ - 1};
          pg8::gemm_phase<pg8::EpiProj, pg8::StaticOrder, true, true>(L, gm, S, E, CUR_TID()); }
#endif
        GRID_BAR();


#ifndef NO_PH_B1
        {
            using namespace att;
            PHASE_IDS();
            const int r32 = lane & 31, hi = lane >> 5, rb = wave & 3, half = wave >> 2;
            for (int u = bx; u < 1024; u += G) {
                const int h = u & 7, gc = u >> 3;
                const float lgf2 = -__expf(dec_f[h]) * 1.4426950408889634f, lgb2 = -__expf(dec_b[h]) * 1.4426950408889634f;
                const bf16* Kp = PROJ + (size_t)gc * 128 * LDP + C_RK + h * 128;
                const bf16* Vp = PROJ + (size_t)gc * 128 * LDP + C_RV + h * 256;
                int t2 = tid; asm volatile("" : "+v"(t2));
#pragma unroll
                for (int i = 0; i < 4; ++i) { const int p = t2 + 512 * i, tok = p >> 4, cb = p & 15;
                    const v4u v = *(const v4u*)(Kp + (size_t)tok * LDP + cb * 8);
                    const float zf = __builtin_amdgcn_exp2f(lgf2 * (float)(127 - tok)), zb = __builtin_amdgcn_exp2f(lgb2 * (float)tok);
                    v4u of, ob;
#pragma unroll
                    for (int j = 0; j < 4; ++j) { const float a = bflo(v[j]), b = bfhi(v[j]); of[j] = pk2(a * zf, b * zf); ob[j] = pk2(a * zb, b * zb); }
                    const int off = (tok >> 6) * 16384 + v_st(tok & 63, cb * 8);
                    *(LAS v4u*)(L + off) = of; *(LAS v4u*)(L + 32768 + off) = ob; }
#pragma unroll
                for (int i = 0; i < 8; ++i) { const int p = t2 + 512 * i, tok = p >> 5, col = (p & 31) * 8;
                    const v4u v = *(const v4u*)(Vp + (size_t)tok * LDP + col);
                    *(LAS v4u*)(L + 65536 + ((tok >> 6) * 2 + (col >> 7)) * 16384 + v_st(tok & 63, col & 127)) = v; }
                __syncthreads();
                const int abase = v_rd_base(lane) + rb * 512, bbase = 65536 + v_rd_base(lane) + half * 16384;
#pragma unroll
                for (int dir = 0; dir < 2; ++dir) {
                    f32x16 acc[4] = {};
#pragma unroll
                    for (int tt = 0; tt < 2; ++tt) {
                        const int ab = abase + dir * 32768 + tt * 16384, bb = bbase + tt * 32768;
#define B1_STEP(KS) do { const s16x4 al = tr_read<v_rd_off(0, KS, 0)>(ab), ah = tr_read<v_rd_off(0, KS, 1)>(ab); \
                        const s16x4 l0 = tr_read<v_rd_off(0, KS, 0)>(bb), h0 = tr_read<v_rd_off(0, KS, 1)>(bb), l1 = tr_read<v_rd_off(1, KS, 0)>(bb), h1 = tr_read<v_rd_off(1, KS, 1)>(bb); \
                        const s16x4 l2 = tr_read<v_rd_off(2, KS, 0)>(bb), h2 = tr_read<v_rd_off(2, KS, 1)>(bb), l3 = tr_read<v_rd_off(3, KS, 0)>(bb), h3 = tr_read<v_rd_off(3, KS, 1)>(bb); \
                        asm volatile("s_waitcnt lgkmcnt(0)" ::: "memory"); SBAR(); const bf16x8 A = PKLH(al, ah); \
                        acc[0] = __builtin_amdgcn_mfma_f32_32x32x16_bf16(A, PKLH(l0, h0), acc[0], 0, 0, 0); acc[1] = __builtin_amdgcn_mfma_f32_32x32x16_bf16(A, PKLH(l1, h1), acc[1], 0, 0, 0); \
                        acc[2] = __builtin_amdgcn_mfma_f32_32x32x16_bf16(A, PKLH(l2, h2), acc[2], 0, 0, 0); acc[3] = __builtin_amdgcn_mfma_f32_32x32x16_bf16(A, PKLH(l3, h3), acc[3], 0, 0, 0); } while (0)
                        B1_STEP(0); B1_STEP(1); B1_STEP(2); B1_STEP(3);
#undef B1_STEP
                    }
                    bf16* dst = KVB + ((size_t)(h * 128 + gc) * 2 + dir) * 32768 + (size_t)(rb * 32) * 256 + half * 128 + r32;
#pragma unroll
                    for (int r = 0; r < 16; ++r)
#pragma unroll
                        for (int d0 = 0; d0 < 4; ++d0) dst[(size_t)crow(r, hi) * 256 + d0 * 32] = (bf16)f2bf(acc[d0][r]);
                }
                __syncthreads();
            }
        }
#endif
        GRID_BAR();

#ifndef NO_PH_B2
        {
            PHASE_IDS();
            const int nseq = TOK / SEQ; const long ntask = (long)8 * nseq * 2 * 8192;
            for (long t = gtid; t < ntask; t += NGT) {
                const int e4 = (int)(t & 8191), dir = (int)(t >> 13) & 1; const int sh = (int)(t >> 14); const int sq = sh % nseq, h = sh / nseq;
                const float dec = __expf(-__expf(dir ? dec_b[h] : dec_f[h]) * 128.0f);
                const size_t off = ((size_t)(h * 128 + sq * NC) * 2 + dir) * 32768 + (size_t)e4 * 4;
                const bf16* src = KVB + off; bf16* dstp = SB + off;
                f32x4 s = {0.f, 0.f, 0.f, 0.f};
                for (int c0 = 0; c0 < NC; c0 += 8) {
                    v2u kv[8];
#pragma unroll
                    for (int j = 0; j < 8; ++j) { const int c = dir ? (NC - 1 - c0 - j) : (c0 + j); kv[j] = *(const v2u*)(src + (size_t)c * 65536); }
#pragma unroll
                    for (int j = 0; j < 8; ++j) { const int c = dir ? (NC - 1 - c0 - j) : (c0 + j);
                        v2u w; w.x = pk2(s[0], s[1]); w.y = pk2(s[2], s[3]); *(v2u*)(dstp + (size_t)c * 65536) = w;
                        s = s * dec + (f32x4){bflo(kv[j][0]), bfhi(kv[j][0]), bflo(kv[j][1]), bfhi(kv[j][1])}; }
                }
            }
        }
#endif
        GRID_BAR();

#ifndef NO_PH_B3
        {
            using namespace att;
            PHASE_IDS();
            const int r32 = lane & 31, hi = lane >> 5, rb = wave & 3, half = wave >> 2;
            char* Lg = (char*)lds;
            for (int u = bx; u < 1024; u += G) {
                const int h = u & 7, gc = u >> 3;
                const float lgf2 = -__expf(dec_f[h]) * 1.4426950408889634f, lgb2 = -__expf(dec_b[h]) * 1.4426950408889634f;
                const size_t row0 = (size_t)gc * 128;
                const bf16* Qp = PROJ + row0 * LDP + C_RQ + h * 128;
                const bf16* Kp = PROJ + row0 * LDP + C_RK + h * 128;
                const bf16* Vp = PROJ + row0 * LDP + C_RV + h * 256;
                const bf16* Sf = SB + ((size_t)(h * 128 + gc) * 2 + 0) * 32768; const bf16* Sb = Sf + 32768;
                int t2 = tid; asm volatile("" : "+v"(t2));
#pragma unroll
                for (int i = 0; i < 4; ++i) { const int p = t2 + 512 * i, tok = p >> 4, cb = p & 15;
                    const v4u v = *(const v4u*)(Kp + (size_t)tok * LDP + cb * 8);
                    *(LAS v4u*)(L + (tok >> 6) * 16384 + KSWZ(tok & 63, cb * 16)) = v; }
#pragma unroll
                for (int i = 0; i < 8; ++i) { const int p = t2 + 512 * i, tok = p >> 5, col = (p & 31) * 8;
                    const v4u v = *(const v4u*)(Vp + (size_t)tok * LDP + col);
                    *(LAS v4u*)(L + 32768 + ((tok >> 6) * 2 + (col >> 7)) * 16384 + v_st(tok & 63, col & 127)) = v; }
                bf16x8 qr[8];
                { const bf16* Qw = Qp + (size_t)(rb * 32 + r32) * LDP + hi * 8;
#pragma unroll
                  for (int d0 = 0; d0 < 8; ++d0) qr[d0] = *(const bf16x8*)(Qw + d0 * 16); }
                __syncthreads();
                f32x16 o[4] = {};
                const int vb = 32768 + v_rd_base(lane) + half * 16384;
                const int irow = rb * 32 + r32;
#pragma unroll
                for (int tt = 0; tt < 2; ++tt) {
                    f32x16 p0, p1; bf16x8 pa0, pa1, pa2, pa3;
                    qkt(p0, p1, (const att::hbf*)(Lg + tt * 16384), qr, r32, hi);
                    int dbase = irow - tt * 64 - 4 * hi; asm volatile("" : "+v"(dbase));
#pragma unroll
                    for (int r = 0; r < 16; ++r) {
                        const int d0 = dbase - ((r & 3) + 8 * (r >> 2)), d1 = d0 - 32;
                        float m0 = __builtin_amdgcn_exp2f((d0 > 0 ? lgf2 : -lgb2) * (float)d0); m0 = d0 == 0 ? 2.0f : m0;
                        float m1 = __builtin_amdgcn_exp2f((d1 > 0 ? lgf2 : -lgb2) * (float)d1); m1 = d1 == 0 ? 2.0f : m1;
                        p0[r] *= m0; p1[r] *= m1; }
                    PK4(p0, 0, pa0); PK4(p0, 8, pa1); PK4(p1, 0, pa2); PK4(p1, 8, pa3);
                    pv_d0(o, vb + tt * 32768, pa0, pa1, pa2, pa3);
                }
#pragma unroll
                for (int dir = 0; dir < 2; ++dir) {
                    __syncthreads();
                    const bf16* Sp = dir ? Sb : Sf;
                    int t3 = tid; asm volatile("" : "+v"(t3));
#pragma unroll
                    for (int i = 0; i < 8; ++i) { const int p = t3 + 512 * i, rw = p >> 5, col = (p & 31) * 8;
                        const v4u w = *(const v4u*)(Sp + (size_t)rw * 256 + col);
                        *(LAS v4u*)(L + 32768 + ((rw >> 6) * 2 + (col >> 7)) * 16384 + v_st(rw & 63, col & 127)) = w; }
                    const float xi = dir ? __builtin_amdgcn_exp2f(lgb2 * (float)(128 - irow)) : __builtin_amdgcn_exp2f(lgf2 * (float)(irow + 1));
                    bf16x8 qs[8];
#pragma unroll
                    for (int d0 = 0; d0 < 8; ++d0) { const v4u w = __builtin_bit_cast(v4u, qr[d0]); v4u x;
#pragma unroll
                        for (int j = 0; j < 4; ++j) x[j] = cvtpk(bflo(w[j]) * xi, bfhi(w[j]) * xi);
                        qs[d0] = __builtin_bit_cast(bf16x8, x); }
                    __syncthreads();
                    pv_d0(o, vb, qs[0], qs[1], qs[2], qs[3]);
                    pv_d0(o, vb + 32768, qs[4], qs[5], qs[6], qs[7]);
                }
                __syncthreads();
                LAS float* ost = (LAS float*)L;
#pragma unroll
                for (int r = 0; r < 16; ++r)
#pragma unroll
                    for (int d0 = 0; d0 < 4; ++d0) ost[(rb * 32 + crow(r, hi)) * 260 + half * 128 + d0 * 32 + r32] = o[d0][r];
                __syncthreads();
                const f32x4 gwv = *(const f32x4*)(gn_w + h * 256 + 4 * lane);
                v2u gts[16];
#pragma unroll
                for (int rr = 0; rr < 16; ++rr) gts[rr] = *(const v2u*)(PROJ + (row0 + wave * 16 + rr) * LDP + C_RG + h * 256 + 4 * lane);
#pragma unroll
                for (int rr = 0; rr < 16; ++rr) {
                    const int row = wave * 16 + rr;
                    const f32x4 v = *(const LAS f32x4*)(ost + row * 260 + 4 * lane);
                    const float mean = wave_sum((v[0] + v[1]) + (v[2] + v[3]), lane) * (1.0f / 256.0f);
                    const f32x4 d = v - mean;
                    const float var = wave_sum((d[0] * d[0] + d[1] * d[1]) + (d[2] * d[2] + d[3] * d[3]), lane) * (1.0f / 256.0f);
                    const float rstd = 1.0f / sqrtf(var + GN_EPS);
                    const v2u gt = gts[rr];
                    const float g0 = bflo(gt[0]), g1 = bfhi(gt[0]), g2 = bflo(gt[1]), g3 = bfhi(gt[1]);
                    v2u w; w.x = pk2(pg8::silu_f(g0) * d[0] * rstd * gwv[0], pg8::silu_f(g1) * d[1] * rstd * gwv[1]);
                    w.y = pk2(pg8::silu_f(g2) * d[2] * rstd * gwv[2], pg8::silu_f(g3) * d[3] * rstd * gwv[3]);
                    *(v2u*)(XB + (row0 + row) * DM + h * 256 + 4 * lane) = w;
                }
                __syncthreads();
            }
        }
#endif
        GRID_BAR();

#ifndef NO_PH_ATT
        {
            const float lam = __uint_as_float(__builtin_amdgcn_readfirstlane(__float_as_uint(PAR[PAR_LAM])));
            for (int i = 0; bx + i * G < 512; ++i) {
                int set, qb;
                if (G == 256) { const int xcd = bx & 7, jb = bx >> 3;
                    if (g == 0) { set = (xcd >> 1) + 4 * i; qb = (xcd & 1) * 32 + jb; } else { set = xcd * 2 + (jb >> 4) + 16 * i; qb = jb & 15; } }
                else { const int u = bx + i * G; if (g == 0) { set = u >> 6; qb = u & 63; } else { set = u >> 4; qb = u & 15; } }
                const int h = set & 7, sq = set >> 3;
                const size_t krow = (size_t)sq * SEQ, qrow = krow + (size_t)qb * 256;
                const att::hbf* Vp = (const att::hbf*)(PROJ + krow * LDP + C_DV + h * 256);
                float* stash = OS + (size_t)bx * 65536;
                { const att::hbf* Qp = (const att::hbf*)(PROJ + qrow * LDP + C_DQ + (2 * h) * 128);
                  const att::hbf* Kp = (const att::hbf*)(PROJ + krow * LDP + C_DK + (2 * h) * 128);
                  att::attn256_unit<0>(Qp, Kp, Vp, SEQ, (char*)lds, CUR_TID(), stash, nullptr, 0.f, nullptr); }
                { const att::hbf* Qp = (const att::hbf*)(PROJ + qrow * LDP + C_DQ + (2 * h + 1) * 128);
                  const att::hbf* Kp = (const att::hbf*)(PROJ + krow * LDP + C_DK + (2 * h + 1) * 128);
                  att::attn256_unit<1>(Qp, Kp, Vp, SEQ, (char*)lds, CUR_TID(), stash, XB + qrow * DM + 2048 + h * 256, lam, subln_w); }
            }
        }
#endif
        GRID_BAR();


#ifndef NO_PH_P3
        { pg8::Gemm gm{XB, Wout_t, TOK, DM, DM}; pg8::StaticOrder S; S.init(TOK, DM, G, bx);
          pg8::EpiBf16 E{MP, DM};
          pg8::gemm_phase<pg8::EpiBf16, pg8::StaticOrder, true, true>(L, gm, S, E, CUR_TID()); }
#endif
        GRID_BAR();

#ifndef NO_PH_LN1
        { PHASE_IDS();
        for (int row = gw; row < TOK; row += NGW) {
            const float* xr = xin + (size_t)row * DM; const bf16* mr = MP + (size_t)row * DM; f32x4 v[16]; float s = 0.f;
#pragma unroll
            for (int j = 0; j < 16; ++j) { const f32x4 xv = *(const f32x4*)(xr + 4 * lane + 256 * j); const v2u m = *(const v2u*)(mr + 4 * lane + 256 * j);
                v[j] = xv * DEEP_ALPHA + (f32x4){bflo(m[0]), bfhi(m[0]), bflo(m[1]), bfhi(m[1])}; s += (v[j][0] + v[j][1]) + (v[j][2] + v[j][3]); }
            const float mean = wave_sum(s, lane) * (1.0f / DM); float q = 0.f;
#pragma unroll
            for (int j = 0; j < 16; ++j) { v[j] = v[j] - mean; q += (v[j][0] * v[j][0] + v[j][1] * v[j][1]) + (v[j][2] * v[j][2] + v[j][3] * v[j][3]); }
            const float rstd = 1.0f / sqrtf(wave_sum(q, lane) * (1.0f / DM) + LN_EPS); float am = 0.f;
#pragma unroll
            for (int j = 0; j < 16; ++j) { const f32x4 gg = *(const f32x4*)(ln1_g + 4 * lane + 256 * j), bb = *(const f32x4*)(ln1_b + 4 * lane + 256 * j);
                const f32x4 y = v[j] * rstd * gg + bb; v[j] = y; am = fmaxf(fmaxf(am, fmaxf(fabsf(y[0]), fabsf(y[1]))), fmaxf(fabsf(y[2]), fabsf(y[3]))); }
            am = fmaxf(wave_max(am, lane), 1e-30f);
            const float qs = 127.f / am;
            if (lane == 0) SAq[row] = am * (1.0f / (127.f * 127.f));
#pragma unroll
            for (int j = 0; j < 16; ++j) { const f32x4 y = v[j];
                v2u w; w.x = pk2(y[0], y[1]); w.y = pk2(y[2], y[3]); *(v2u*)(XB + (size_t)row * DM + 4 * lane + 256 * j) = w;
                XQ[(size_t)row * (DM / 4) + lane + 64 * j] = pk_i8x4(y[0] * qs, y[1] * qs, y[2] * qs, y[3] * qs); }
        } }
#endif
        GRID_BAR();

#ifndef NO_PH_P5
        { pg8::Gemm gm{(const pg8::bf16_t*)XQ, Wgu_t, TOK, NGU, DM / 2}; pg8::StaticOrder S; S.init(TOK, NGU, G, bx);
          pg8::EpiSwiGLUQ E{HB, DFF, SAq, (const float*)(ctl + CW_CMAX)};
          pg8::gemm_phase<pg8::EpiSwiGLUQ, pg8::StaticOrder, true, true, 0, true>(L, gm, S, E, CUR_TID()); }
#endif
        GRID_BAR();

#ifndef NO_PH_P6
        { pg8::Gemm gm{HB, Wd_t, TOK, DM, pg8::HROWB / 2}; pg8::StaticOrder S; S.init(TOK, DM, G, bx);
          pg8::EpiBf16NP E{MP, DM};
          pg8::gemm_phase<pg8::EpiBf16NP, pg8::StaticOrder, true, true, pg8::KT16>(L, gm, S, E, CUR_TID()); }
#endif
        GRID_BAR();

#ifndef NO_PH_LN2
        { PHASE_IDS();
        for (int row = gw; row < TOK; row += NGW) {
            const bf16* xr = XB + (size_t)row * DM; const bf16* mr = MP + (size_t)row * DM; float* yr = outg + (size_t)row * DM; f32x4 v[16]; float s = 0.f;
#pragma unroll
            for (int j = 0; j < 16; ++j) { const v2u xv = *(const v2u*)(xr + 4 * lane + 256 * j); const v2u m = *(const v2u*)(mr + 4 * lane + 256 * j);
                v[j] = (f32x4){bflo(xv[0]), bfhi(xv[0]), bflo(xv[1]), bfhi(xv[1])} * DEEP_ALPHA + (f32x4){bflo(m[0]), bfhi(m[0]), bflo(m[1]), bfhi(m[1])}; s += (v[j][0] + v[j][1]) + (v[j][2] + v[j][3]); }
            const float mean = wave_sum(s, lane) * (1.0f / DM); float q = 0.f;
#pragma unroll
            for (int j = 0; j < 16; ++j) { v[j] = v[j] - mean; q += (v[j][0] * v[j][0] + v[j][1] * v[j][1]) + (v[j][2] * v[j][2] + v[j][3] * v[j][3]); }
            const float rstd = 1.0f / sqrtf(wave_sum(q, lane) * (1.0f / DM) + LN_EPS);
#pragma unroll
            for (int j = 0; j < 16; ++j) { const f32x4 gg = *(const f32x4*)(ln2_g + 4 * lane + 256 * j), bb = *(const f32x4*)(ln2_b + 4 * lane + 256 * j);
                *(f32x4*)(yr + 4 * lane + 256 * j) = v[j] * rstd * gg + bb; }
            if (g == 0) {
                const float* xs = args.in[1] + (size_t)row * DM;
#pragma unroll
                for (int jb = 0; jb < 4; ++jb) { f32x4 t[4];
#pragma unroll
                    for (int j = 0; j < 4; ++j) t[j] = *(const f32x4*)(xs + 4 * lane + 256 * (4 * jb + j));
#pragma unroll
                    for (int j = 0; j < 4; ++j) { v2u w; w.x = pk2(t[j][0], t[j][1]); w.y = pk2(t[j][2], t[j][3]); *(v2u*)(XB + (size_t)row * DM + 4 * lane + 256 * (4 * jb + j)) = w; } }
            }
        } }
#endif
        GRID_BAR();
    }
}

extern "C" void kernel_launch(void* const* d_in, const int* in_sizes, int n_in, void* d_out, int out_size, void* d_ws, size_t ws_size, hipStream_t stream) {
    static int grid = 0;
    if (grid == 0) {
        if (n_in != 19 || in_sizes[0] != TOK * DM || in_sizes[1] != TOK * DM || out_size != 2 * TOK * DM || ws_size < WS_END) {
            fprintf(stderr, "kernel_launch: unexpected shapes: n_in %d in0 %d out %d ws %zu (need >= %zu); nothing launched\n", n_in, n_in > 0 ? in_sizes[0] : -1, out_size, ws_size, (size_t)WS_END); grid = -1; return; }
        int dev = 0, cus = 0, per_cu = 0;
        if (hipGetDevice(&dev) != hipSuccess || hipDeviceGetAttribute(&cus, hipDeviceAttributeMultiprocessorCount, dev) != hipSuccess) { fprintf(stderr, "kernel_launch: device query failed\n"); grid = -1; return; }
        if (hipFuncSetAttribute((const void*)mega_fwd, hipFuncAttributeMaxDynamicSharedMemorySize, LDS_BYTES) != hipSuccess) { fprintf(stderr, "kernel_launch: hipFuncSetAttribute failed\n"); grid = -1; return; }
        if (hipOccupancyMaxActiveBlocksPerMultiprocessor(&per_cu, (const void*)mega_fwd, NWAVES * 64, LDS_BYTES) != hipSuccess || per_cu < 1)
            fprintf(stderr, "kernel_launch: note: occupancy query reports %d workgroups per CU\n", per_cu);
        (void)hipGetLastError();
        grid = cus;
    }
    if (grid < 0) return;
    if (hipMemsetAsync((char*)d_ws + WS_CTL, 0, CTL_ZERO_BYTES, stream) != hipSuccess) { fprintf(stderr, "kernel_launch: memset failed\n"); return; }
    Args a{};
    for (int i = 0; i < 19; ++i) a.in[i] = (const float*)d_in[i];
    a.out = (float*)d_out; a.ws = (unsigned char*)d_ws;
    hipLaunchKernelGGL(mega_fwd, dim3(grid), dim3(NWAVES * 64), LDS_BYTES, stream, a);
    const hipError_t le = hipPeekAtLastError();
    if (le != hipSuccess) fprintf(stderr, "kernel_launch: launch failed: %s\n", hipGetErrorName(le));
}
```

```cpp
#include <hip/hip_runtime.h>
#include <hip/hip_bf16.h>
#include <cstdio>
#include <cstdint>

namespace pg8 {
#define PG8_LAS __attribute__((address_space(3)))
typedef unsigned short bf16_t;
typedef short bf16x8 __attribute__((ext_vector_type(8)));
typedef float f32x4 __attribute__((ext_vector_type(4)));
typedef int i32x4 __attribute__((ext_vector_type(4)));
typedef int i32x8 __attribute__((ext_vector_type(8)));
typedef unsigned u32x4 __attribute__((ext_vector_type(4)));
constexpr int BM = 256, BK = 64, HALF = 128, HTB = HALF * BK * 2, STAGE_BYTES = 8 * HTB, NXCD = 8, WGM = 8;

__host__ __device__ __forceinline__ int lds_byte(int r, int c) { const int st = (r >> 4) * 2 + (c >> 5), rr = r & 15, cc = c & 31, ob = rr * 64 + cc * 2; return st * 1024 + (ob ^ (((ob >> 9) & 1) << 5)); }
__host__ __device__ __forceinline__ void stage_rc(int b, int& R, int& C) { const int st = b / 1024, sb = b % 1024, swz = sb ^ (((sb >> 9) & 1) << 5); R = (st >> 1) * 16 + swz / 64; C = (st & 1) * 32 + (swz % 64) / 2; }
__host__ __device__ __forceinline__ int perm32(int rho) { const int n = rho >> 4, i = rho & 15; return 8 * (i >> 2) + 4 * n + (i & 3); }

struct Unit { int pm, pn; };
struct Gemm { const bf16_t* A; const bf16_t* Bt; int M, N, K; };

struct StaticOrder {
    int nM, nN, nwg, G, c;
    __host__ __device__ void init(int M, int N, int G_, int c_) { nM = M / BM; nN = N / BM; nwg = nM * nN; G = G_; c = c_; }
    __host__ __device__ bool next(int i, Unit& u) const {
        const long L = (long)i * G + c; if (L >= nwg) return false;
        int wgid = (int)L; { const int q = nwg / NXCD, r = nwg % NXCD, xcd = wgid % NXCD, off = wgid / NXCD; wgid = (xcd < r ? xcd * (q + 1) : r * (q + 1) + (xcd - r) * q) + off; }
        const int nig = WGM * nN, gid = wgid / nig, fm = gid * WGM, gsz = (nM - fm) < WGM ? (nM - fm) : WGM;
        u.pm = fm + ((wgid % nig) % gsz); u.pn = (wgid % nig) / gsz; return true;
    }
    __device__ __forceinline__ void a_ready(const Unit&) const {}
    __device__ __forceinline__ void done(const Unit&) const {}
};

__device__ __forceinline__ unsigned cvt_pk_bf16(float lo, float hi) { unsigned r; asm volatile("v_cvt_pk_bf16_f32 %0, %1, %2" : "=v"(r) : "v"(lo), "v"(hi)); return r; }

struct EpiBf16 {
    static constexpr bool PERM = true, AFTER_DRAIN = false;
    bf16_t* O; int ldc;
    __device__ __forceinline__ void operator()(const f32x4 (&acc)[2][2][4][2], const Unit& u, int wr, int wc, int fr, int fq) const {
        const int row0 = u.pm * BM + wr * 64 + fr; const int col0 = u.pn * BM + wc * 32 + 8 * fq;
#pragma unroll
        for (int ai = 0; ai < 2; ++ai)
#pragma unroll
            for (int m = 0; m < 4; ++m) { bf16_t* rowp = O + (size_t)(row0 + ai * HALF + m * 16) * ldc + col0;
#pragma unroll
                for (int bj = 0; bj < 2; ++bj) { const f32x4 v0 = acc[ai][bj][m][0], v1 = acc[ai][bj][m][1];
                    u32x4 w; w.x = cvt_pk_bf16(v0[0], v0[1]); w.y = cvt_pk_bf16(v0[2], v0[3]); w.z = cvt_pk_bf16(v1[0], v1[1]); w.w = cvt_pk_bf16(v1[2], v1[3]);
                    *(u32x4*)(rowp + bj * HALF) = w; } }
    }
};
struct EpiBf16NP {
    static constexpr bool PERM = false, AFTER_DRAIN = false;
    bf16_t* O; int ldc;
    __device__ __forceinline__ void operator()(const f32x4 (&acc)[2][2][4][2], const Unit& u, int wr, int wc, int fr, int fq) const {
        typedef unsigned u32x2 __attribute__((ext_vector_type(2)));
        const int row0 = u.pm * BM + wr * 64 + fr; const int col0 = u.pn * BM + wc * 32 + 4 * fq;
#pragma unroll
        for (int ai = 0; ai < 2; ++ai)
#pragma unroll
            for (int m = 0; m < 4; ++m) { bf16_t* rowp = O + (size_t)(row0 + ai * HALF + m * 16) * ldc + col0;
#pragma unroll
                for (int bj = 0; bj < 2; ++bj)
#pragma unroll
                    for (int n = 0; n < 2; ++n) { const f32x4 v = acc[ai][bj][m][n]; u32x2 w; w.x = cvt_pk_bf16(v[0], v[1]); w.y = cvt_pk_bf16(v[2], v[3]);
                        *(u32x2*)(rowp + bj * HALF + n * 16) = w; } }
    }
};
struct EpiProj {
    static constexpr bool PERM = true, AFTER_DRAIN = false;
    bf16_t* O; int ldc; const float* tabR; const float* tabD; int seqmask;
    __device__ __forceinline__ void operator()(const f32x4 (&acc)[2][2][4][2], const Unit& u, int wr, int wc, int fr, int fq) const {
        typedef float f32x8 __attribute__((ext_vector_type(8)));
        const int row0 = u.pm * BM + wr * 64 + fr; const int col0 = u.pn * BM + wc * 32 + 8 * fq;
        const int pn = u.pn;
        const bool ret = pn < 8, dif = pn >= 24 && pn < 40;
        const float sc = (pn >= 4 && pn < 8) ? 0.088388347648318440f : ((pn >= 24 && pn < 32) ? 0.088388347648318440f * 1.4426950408889634f : 1.0f);
        const bool rot = ret || (dif && wc == 0);
        f32x8 csa[2][4];
#pragma unroll
        for (int ai = 0; ai < 2; ++ai)
#pragma unroll
            for (int m = 0; m < 4; ++m) { const int row = row0 + ai * HALF + m * 16; csa[ai][m] = (f32x8){1.f, 0.f, 1.f, 0.f, 1.f, 0.f, 1.f, 0.f};
                if (rot) { const int pos = row & seqmask; csa[ai][m] = ret ? *(const f32x8*)(tabR + ((size_t)pos * 64 + 4 * (4 * wc + fq)) * 2) : *(const f32x8*)(tabD + ((size_t)pos * 16 + 4 * fq) * 2); } }
#pragma unroll
        for (int ai = 0; ai < 2; ++ai)
#pragma unroll
            for (int m = 0; m < 4; ++m) { const int row = row0 + ai * HALF + m * 16; bf16_t* rowp = O + (size_t)row * ldc + col0;
                const f32x8 cs = csa[ai][m];
#pragma unroll
                for (int bj = 0; bj < 2; ++bj) { const f32x4 v0 = acc[ai][bj][m][0], v1 = acc[ai][bj][m][1]; f32x4 o0, o1;
#pragma unroll
                    for (int k = 0; k < 4; ++k) { o0[k] = (v0[k] * cs[2 * k] - v1[k] * cs[2 * k + 1]) * sc; o1[k] = (v1[k] * cs[2 * k] + v0[k] * cs[2 * k + 1]) * sc; }
                    u32x4 w; w.x = cvt_pk_bf16(o0[0], o0[1]); w.y = cvt_pk_bf16(o0[2], o0[3]); w.z = cvt_pk_bf16(o1[0], o1[1]); w.w = cvt_pk_bf16(o1[2], o1[3]);
                    *(u32x4*)(rowp + bj * HALF) = w; } }
    }
};
__device__ __forceinline__ float silu_f(float x) { return x * __builtin_amdgcn_rcpf(1.0f + __builtin_amdgcn_exp2f(-1.4426950408889634f * x)); }
constexpr int H16 = 1536, H8 = 9472, HROWB = 12544, KT16 = H16 / 64;
static_assert(H16 * 2 + H8 == HROWB && H16 % 128 == 0 && H8 % 256 == 0 && (KT16 % 2) == 0, "mixed hidden row");
template <bool Q> struct EpiSwiGLUT {
    static constexpr bool PERM = true, AFTER_DRAIN = false;
    bf16_t* O; int ldc; const float* SA; const float* CM;
    static __device__ __forceinline__ f32x4 deq(const f32x4 a, const float sa, const f32x4 cm) { if constexpr (!Q) return a; else { const i32x4 i = __builtin_bit_cast(i32x4, a); return (f32x4){(float)i[0] * (sa * cm[0]), (float)i[1] * (sa * cm[1]), (float)i[2] * (sa * cm[2]), (float)i[3] * (sa * cm[3])}; } }
    __device__ __forceinline__ void operator()(const f32x4 (&acc)[2][2][4][2], const Unit& u, int wr, int wc, int fr, int fq) const {
        const int row0 = u.pm * BM + wr * 64 + fr; const int col0 = u.pn * HALF + wc * 32 + 8 * fq;
        f32x4 cg0 = {1.f, 1.f, 1.f, 1.f}, cg1 = cg0, cu0 = cg0, cu1 = cg0;
        if constexpr (Q) { cg0 = *(const f32x4*)(CM + col0); cg1 = *(const f32x4*)(CM + col0 + 4); cu0 = *(const f32x4*)(CM + ldc + col0); cu1 = *(const f32x4*)(CM + ldc + col0 + 4); }
        if (u.pn * HALF >= H16) {
#pragma unroll
            for (int ai = 0; ai < 2; ++ai)
#pragma unroll
                for (int m = 0; m < 4; ++m) { unsigned char* rowp = (unsigned char*)O + (size_t)(row0 + ai * HALF + m * 16) * HROWB + H16 * 2 + (col0 - H16);
                    float sa = 1.f; if constexpr (Q) sa = SA[row0 + ai * HALF + m * 16];
                    const f32x4 g0 = deq(acc[ai][0][m][0], sa, cg0), g1 = deq(acc[ai][0][m][1], sa, cg1), u0 = deq(acc[ai][1][m][0], sa, cu0), u1 = deq(acc[ai][1][m][1], sa, cu1);
                    float v[8];
#pragma unroll
                    for (int j = 0; j < 4; ++j) { v[j] = __builtin_amdgcn_fmed3f(silu_f(g0[j]) * u0[j] * 4.0f, -448.f, 448.f); v[4 + j] = __builtin_amdgcn_fmed3f(silu_f(g1[j]) * u1[j] * 4.0f, -448.f, 448.f); }
                    int w0 = __builtin_amdgcn_cvt_pk_fp8_f32(v[0], v[1], 0, false); w0 = __builtin_amdgcn_cvt_pk_fp8_f32(v[2], v[3], w0, true);
                    int w1 = __builtin_amdgcn_cvt_pk_fp8_f32(v[4], v[5], 0, false); w1 = __builtin_amdgcn_cvt_pk_fp8_f32(v[6], v[7], w1, true);
                    typedef int i32x2 __attribute__((ext_vector_type(2)));
                    *(i32x2*)rowp = (i32x2){w0, w1}; }
            return; }
#pragma unroll
        for (int ai = 0; ai < 2; ++ai)
#pragma unroll
            for (int m = 0; m < 4; ++m) { bf16_t* rowp = (bf16_t*)((unsigned char*)O + (size_t)(row0 + ai * HALF + m * 16) * HROWB) + col0;
                float sa = 1.f; if constexpr (Q) sa = SA[row0 + ai * HALF + m * 16];
                    const f32x4 g0 = deq(acc[ai][0][m][0], sa, cg0), g1 = deq(acc[ai][0][m][1], sa, cg1), u0 = deq(acc[ai][1][m][0], sa, cu0), u1 = deq(acc[ai][1][m][1], sa, cu1);
                f32x4 v0, v1;
#pragma unroll
                for (int j = 0; j < 4; ++j) { v0[j] = silu_f(g0[j]) * u0[j]; v1[j] = silu_f(g1[j]) * u1[j]; }
                u32x4 w; w.x = cvt_pk_bf16(v0[0], v0[1]); w.y = cvt_pk_bf16(v0[2], v0[3]); w.z = cvt_pk_bf16(v1[0], v1[1]); w.w = cvt_pk_bf16(v1[2], v1[3]);
                *(u32x4*)rowp = w; }
    }
};
typedef EpiSwiGLUT<false> EpiSwiGLU; typedef EpiSwiGLUT<true> EpiSwiGLUQ;
constexpr int F8_SC_W = 0x78787878, F8_SC_H = 0x7d7d7d7d;
__device__ __forceinline__ i32x8 cat8(bf16x8 lo, bf16x8 hi) { const i32x4 a = __builtin_bit_cast(i32x4, lo), b = __builtin_bit_cast(i32x4, hi); return __builtin_shufflevector(a, b, 0, 1, 2, 3, 4, 5, 6, 7); }
__device__ __forceinline__ void glds_saddr(unsigned voff, const void* sbase, unsigned lds_dst) { unsigned keep;
    asm volatile("s_mov_b32 %0, m0\n\ts_mov_b32 m0, %3\n\ts_nop 0\n\tglobal_load_lds_dwordx4 %1, %2\n\ts_mov_b32 m0, %0" : "=&s"(keep) : "v"(voff), "s"(sbase), "s"(lds_dst) : "memory"); }
template <class Epi, class Sched, bool ALIGN_EPI = false, bool SP2 = false, int KS8 = 0, bool I8 = false>
__device__ __forceinline__ void gemm_phase(PG8_LAS unsigned char* lds, const Gemm g, const Sched& S, const Epi& E, int tid) {
    asm volatile("" : "+v"(tid));
    const int wid = __builtin_amdgcn_readfirstlane(tid >> 6), lane = tid & 63, wr = wid >> 2, wc = wid & 3, fr = lane & 15, fq = lane >> 4;
    const int K = g.K, nt = K / BK;
    unsigned voffA[2], voffB[2];
#pragma unroll
    for (int i = 0; i < 2; ++i) { int R, C; stage_rc(tid * 16 + i * 8192, R, C); const int Rb = Epi::PERM ? ((R & ~31) + perm32(R & 31)) : R;
        voffA[i] = (unsigned)(R * K + C) * 2u; voffB[i] = (unsigned)(Rb * K + C) * 2u; }
    const size_t kstep = (size_t)(BK * 2);
    const size_t hstep = (size_t)HALF * K * 2;
    const size_t tstep = 2 * hstep;
    const unsigned ldsw = (unsigned)wid * 1024u;
    const int aoff = lds_byte(wr * 64 + fr, fq * 8), boff = lds_byte(wc * 32 + fr, fq * 8);
#define PG8_SA(b, h) (((b) * 2 + (h)) * HTB)
#define PG8_SB(b, h) ((4 + (b) * 2 + (h)) * HTB)
#define PG8_STAGE(bufoff, gbase, voff) do { _Pragma("unroll") for (int _i = 0; _i < 2; ++_i) { \
        if constexpr (KS8 > 0) glds_saddr((voff)[_i], (const void*)(gbase), (unsigned)__builtin_amdgcn_readfirstlane((int)(unsigned)(size_t)(lds + (bufoff) + ldsw + _i * 8192))); \
        else __builtin_amdgcn_global_load_lds((const unsigned*)((const char*)(gbase) + (voff)[_i]), (PG8_LAS unsigned*)(lds + (bufoff) + ldsw + _i * 8192), 16, 0, 0); } } while (0)
#define PG8_LDA(dst, b, h) do { _Pragma("unroll") for (int m = 0; m < 4; ++m) _Pragma("unroll") for (int k = 0; k < 2; ++k) dst[m][k] = *(const PG8_LAS bf16x8*)(lds + PG8_SA(b, h) + aoff + m * 2048 + k * 1024); } while (0)
#define PG8_LDB(dst, b, h) do { _Pragma("unroll") for (int n = 0; n < 2; ++n) _Pragma("unroll") for (int k = 0; k < 2; ++k) dst[n][k] = *(const PG8_LAS bf16x8*)(lds + PG8_SB(b, h) + boff + n * 2048 + k * 1024); } while (0)
#define PG8_MMA(ai, bj, At, Bt) do { __builtin_amdgcn_s_setprio(1); _Pragma("unroll") for (int m = 0; m < 4; ++m) _Pragma("unroll") for (int n = 0; n < 2; ++n) _Pragma("unroll") for (int k = 0; k < 2; ++k) \
        acc[ai][bj][m][n] = __builtin_amdgcn_mfma_f32_16x16x32_bf16(Bt[n][k], At[m][k], acc[ai][bj][m][n], 0, 0, 0); __builtin_amdgcn_s_setprio(0); } while (0)
#define PG8_MMA8(ai, bj, At, Bt) do { __builtin_amdgcn_s_setprio(1); _Pragma("unroll") for (int m = 0; m < 4; ++m) _Pragma("unroll") for (int n = 0; n < 2; ++n) \
        acc[ai][bj][m][n] = __builtin_amdgcn_mfma_scale_f32_16x16x128_f8f6f4(cat8(Bt[n][0], Bt[n][1]), cat8(At[m][0], At[m][1]), acc[ai][bj][m][n], 0, 0, 0, F8_SC_W, 0, F8_SC_H); __builtin_amdgcn_s_setprio(0); } while (0)
#define PG8_MMAI(ai, bj, At, Bt) do { __builtin_amdgcn_s_setprio(1); _Pragma("unroll") for (int m = 0; m < 4; ++m) _Pragma("unroll") for (int n = 0; n < 2; ++n) _Pragma("unroll") for (int k = 0; k < 2; ++k) \
        acc[ai][bj][m][n] = __builtin_bit_cast(f32x4, __builtin_amdgcn_mfma_i32_16x16x64_i8(__builtin_bit_cast(i32x4, Bt[n][k]), __builtin_bit_cast(i32x4, At[m][k]), __builtin_bit_cast(i32x4, acc[ai][bj][m][n]), 0, 0, 0)); __builtin_amdgcn_s_setprio(0); } while (0)
#define PG8_WAIT_V(n) asm volatile("s_waitcnt vmcnt(" #n ")" ::: "memory")
#define PG8_WAIT_L(n) asm volatile("s_waitcnt lgkmcnt(" #n ")" ::: "memory")
#define PG8_BAR __builtin_amdgcn_s_barrier()
#define PG8_SCHED __builtin_amdgcn_sched_barrier(0)
    Unit cur, nxt; int ui = 0;
    if (!S.next(0, cur)) return;
    f32x4 acc[2][2][4][2];
#pragma unroll
    for (int a = 0; a < 2; ++a)
#pragma unroll
        for (int b = 0; b < 2; ++b)
#pragma unroll
            for (int m = 0; m < 4; ++m)
#pragma unroll
                for (int n = 0; n < 2; ++n) acc[a][b][m][n] = (f32x4){0.f, 0.f, 0.f, 0.f};
    bf16x8 At[4][2], B0[2][2], B1[2][2];
    const char* cA = (const char*)g.A + (size_t)cur.pm * tstep; const char* cB = (const char*)g.Bt + (size_t)cur.pn * tstep;
    S.a_ready(cur);
    if constexpr (SP2) {
        PG8_STAGE(PG8_SB(0, 0), cB, voffB); PG8_STAGE(PG8_SB(0, 1), cB + hstep, voffB); PG8_STAGE(PG8_SA(0, 0), cA, voffA); PG8_STAGE(PG8_SA(0, 1), cA + hstep, voffA);
        if (wr == 1) PG8_BAR;
        PG8_WAIT_V(2); PG8_BAR;
        PG8_STAGE(PG8_SB(1, 0), cB + kstep, voffB); PG8_STAGE(PG8_SA(1, 0), cA + kstep, voffA); PG8_STAGE(PG8_SB(1, 1), cB + hstep + kstep, voffB);
        PG8_WAIT_V(6); PG8_BAR;
    } else {
        PG8_STAGE(PG8_SB(0, 0), cB, voffB); PG8_STAGE(PG8_SA(0, 0), cA, voffA); PG8_STAGE(PG8_SB(0, 1), cB + hstep, voffB); PG8_STAGE(PG8_SA(0, 1), cA + hstep, voffA);
        if (wr == 1) PG8_BAR;
        PG8_WAIT_V(4); PG8_BAR;
        PG8_STAGE(PG8_SB(1, 0), cB + kstep, voffB); PG8_STAGE(PG8_SA(1, 0), cA + kstep, voffA); PG8_STAGE(PG8_SB(1, 1), cB + hstep + kstep, voffB);
        PG8_WAIT_V(6); PG8_BAR;
    }
    for (;;) {
        const bool has_next = S.next(ui + 1, nxt);
        const char* nA = has_next ? (const char*)g.A + (size_t)nxt.pm * tstep : cA; const char* nB = has_next ? (const char*)g.Bt + (size_t)nxt.pn * tstep : cB;
#define PG8_ITER_HEAD() \
            const bool last = (t == nt - 2); \
            const char* a1 = cA + (size_t)(t + 1) * kstep; \
            const char* a2 = last ? nA : cA + (size_t)(t + 2) * kstep; const char* b2 = last ? nB : cB + (size_t)(t + 2) * kstep; \
            const char* a3 = a2 + kstep; const char* b3 = b2 + kstep; \
            if (last && has_next) S.a_ready(nxt);
#define PG8_ITER_SP2(MM) \
            PG8_LDB(B0, 0, 0); PG8_LDB(B1, 0, 1); PG8_SCHED; PG8_LDA(At, 0, 0); PG8_STAGE(PG8_SA(1, 1), a1 + hstep, voffA); \
            PG8_WAIT_V(8); PG8_WAIT_L(0); PG8_BAR; MM(0, 0, At, B0); MM(0, 1, At, B1); PG8_BAR; PG8_SCHED; \
            PG8_LDA(At, 0, 1); PG8_STAGE(PG8_SB(0, 0), b2, voffB); PG8_STAGE(PG8_SB(0, 1), b2 + hstep, voffB); PG8_STAGE(PG8_SA(0, 0), a2, voffA); \
            PG8_WAIT_V(8); PG8_WAIT_L(0); PG8_BAR; MM(1, 0, At, B0); MM(1, 1, At, B1); PG8_BAR; PG8_SCHED; \
            PG8_LDB(B0, 1, 0); PG8_LDB(B1, 1, 1); PG8_SCHED; PG8_LDA(At, 1, 0); PG8_STAGE(PG8_SA(0, 1), a2 + hstep, voffA); \
            PG8_WAIT_V(8); PG8_WAIT_L(0); PG8_BAR; MM(0, 0, At, B0); MM(0, 1, At, B1); PG8_BAR; PG8_SCHED; \
            PG8_LDA(At, 1, 1); PG8_STAGE(PG8_SB(1, 0), b3, voffB); PG8_STAGE(PG8_SB(1, 1), b3 + hstep, voffB); PG8_STAGE(PG8_SA(1, 0), a3, voffA); \
            PG8_WAIT_V(8); PG8_WAIT_L(0); PG8_BAR; MM(1, 0, At, B0); MM(1, 1, At, B1); PG8_BAR; PG8_SCHED;
        int t = 0;
        if constexpr (SP2 && I8) {
            for (; t < nt; t += 2) { PG8_ITER_HEAD() PG8_ITER_SP2(PG8_MMAI) }
        } else if constexpr (SP2 && KS8 > 0) {
            for (; t < KS8; t += 2) { PG8_ITER_HEAD() PG8_ITER_SP2(PG8_MMA) }
            for (; t < nt; t += 2) { PG8_ITER_HEAD() PG8_ITER_SP2(PG8_MMA8) }
        } else {
        for (; t < nt; t += 2) {
            PG8_ITER_HEAD()
            if constexpr (SP2) {
            PG8_ITER_SP2(PG8_MMA)
            } else {
            PG8_LDB(B0, 0, 0); PG8_SCHED; PG8_LDA(At, 0, 0); PG8_STAGE(PG8_SA(1, 1), a1 + hstep, voffA);
            PG8_WAIT_L(8); PG8_BAR; PG8_WAIT_L(0); PG8_MMA(0, 0, At, B0); PG8_BAR; PG8_SCHED;
            PG8_LDB(B1, 0, 1); PG8_STAGE(PG8_SB(0, 0), b2, voffB);
            PG8_BAR; PG8_WAIT_L(0); PG8_MMA(0, 1, At, B1); PG8_BAR;
            PG8_LDA(At, 0, 1); PG8_STAGE(PG8_SA(0, 0), a2, voffA);
            PG8_BAR; PG8_WAIT_L(0); PG8_MMA(1, 0, At, B0); PG8_BAR; PG8_SCHED;
            PG8_STAGE(PG8_SB(0, 1), b2 + hstep, voffB);
            PG8_WAIT_V(6); PG8_BAR; PG8_MMA(1, 1, At, B1); PG8_BAR;
            PG8_LDB(B0, 1, 0); PG8_SCHED; PG8_LDA(At, 1, 0); PG8_STAGE(PG8_SA(0, 1), a2 + hstep, voffA);
            PG8_WAIT_L(8); PG8_BAR; PG8_WAIT_L(0); PG8_MMA(0, 0, At, B0); PG8_BAR; PG8_SCHED;
            PG8_LDB(B1, 1, 1); PG8_STAGE(PG8_SB(1, 0), b3, voffB);
            PG8_BAR; PG8_WAIT_L(0); PG8_MMA(0, 1, At, B1); PG8_BAR;
            PG8_LDA(At, 1, 1); PG8_STAGE(PG8_SA(1, 0), a3, voffA);
            PG8_BAR; PG8_WAIT_L(0); PG8_MMA(1, 0, At, B0); PG8_BAR; PG8_SCHED;
            PG8_STAGE(PG8_SB(1, 1), b3 + hstep, voffB);
            PG8_WAIT_V(6); PG8_BAR; PG8_MMA(1, 1, At, B1); PG8_BAR;
            }
        }
        }
        if constexpr (ALIGN_EPI) { if (wr == 0) PG8_BAR; }
        if constexpr (!Epi::AFTER_DRAIN) { int l2; asm volatile("v_mbcnt_lo_u32_b32 %0, -1, 0\n\tv_mbcnt_hi_u32_b32 %0, -1, %0" : "=v"(l2));
            E(acc, cur, wr, wc, l2 & 15, l2 >> 4); S.done(cur); }
        if (!has_next) break;
#pragma unroll
        for (int a = 0; a < 2; ++a)
#pragma unroll
            for (int b = 0; b < 2; ++b)
#pragma unroll
                for (int m = 0; m < 4; ++m)
#pragma unroll
                    for (int n = 0; n < 2; ++n) acc[a][b][m][n] = (f32x4){0.f, 0.f, 0.f, 0.f};
        cur = nxt; cA = nA; cB = nB; ++ui;
        if constexpr (ALIGN_EPI) { if (wr == 1) PG8_BAR; }
    }
    PG8_WAIT_V(0);
    if constexpr (!ALIGN_EPI) { if (wr == 0) PG8_BAR; }
    PG8_BAR;
#undef PG8_SA
#undef PG8_SB
#undef PG8_STAGE
#undef PG8_LDA
#undef PG8_LDB
#undef PG8_MMA
#undef PG8_MMA8
#undef PG8_MMAI
#undef PG8_ITER_HEAD
#undef PG8_ITER_SP2
#undef PG8_WAIT_V
#undef PG8_WAIT_L
#undef PG8_BAR
#undef PG8_SCHED
}
}

constexpr int DM = 4096, TOK = 16384, INC = 12288, DFF = 11008, NGU = 2 * DFF;
constexpr int LDP = INC;
constexpr int C_RQ = 0, C_RK = 1024, C_RV = 2048, C_RG = 4096, C_DQ = 6144, C_DK = 8192, C_DV = 10240;
constexpr float LN_EPS = 1e-5f, GN_EPS = 1e-6f, RMS_EPS = 1e-5f;
constexpr float DEEP_ALPHA = 1.189207115002721f;
constexpr float LAMBDA_INIT = 0.2f;

namespace att {
using hbf = __hip_bfloat16;
constexpr int D = 128, NW = 8, QBLK = 32, KVBLK = 64;
constexpr float SCALE = 0.088388347648318440f;
constexpr float QSCALE = SCALE * 1.4426950408889634f;
constexpr float THR = 8.f;
constexpr int SDEPTH = 2;
constexpr int LDQ = LDP, LDK = LDP, LDO = 2048;
constexpr size_t SHM_V = KVBLK * D * 2, SHM_K = KVBLK * D * 2, SHM_ATTN = 2 * SHM_V + 2 * SHM_K + NW * 64 * 4;
using bf16x8 = __attribute__((ext_vector_type(8))) short;
using s16x4  = __attribute__((ext_vector_type(4))) short;
using f32x16 = __attribute__((ext_vector_type(16))) float;
using u32x4  = __attribute__((ext_vector_type(4))) unsigned;
#define KSWZ(row, colB) ((row) * 256 + ((colB) ^ (((row) & 7) << 4)))
#define SBAR() __builtin_amdgcn_sched_barrier(0)
__device__ __forceinline__ int crow(int r, int hi) { return (r & 3) + 8 * (r >> 2) + 4 * hi; }
__device__ __forceinline__ unsigned cvtpk(float lo, float hi) { unsigned r; asm volatile("v_cvt_pk_bf16_f32 %0, %1, %2" : "=v"(r) : "v"(lo), "v"(hi)); return r; }

#define PK4(P, BASE, OUT) do { unsigned a0 = cvtpk(P[BASE + 0], P[BASE + 1]), a1 = cvtpk(P[BASE + 2], P[BASE + 3]);   \
    unsigned b0 = cvtpk(P[BASE + 4], P[BASE + 5]), b1 = cvtpk(P[BASE + 6], P[BASE + 7]);                              \
    auto r0 = __builtin_amdgcn_permlane32_swap(a0, b0, false, false); auto r1 = __builtin_amdgcn_permlane32_swap(a1, b1, false, false); \
    u32x4 w = {r0[0], r1[0], r0[1], r1[1]}; OUT = *reinterpret_cast<bf16x8*>(&w); } while (0)
__device__ __forceinline__ void qkt(f32x16& p0, f32x16& p1, const hbf* Ks, const bf16x8* qr, int r32, int hi) {
  p0 = f32x16{}; p1 = f32x16{};
#pragma unroll
  for (int d0 = 0; d0 < 8; ++d0) { int cb = (d0 * 16 + hi * 8) * 2;
    bf16x8 b0 = *reinterpret_cast<const bf16x8*>((const char*)Ks + KSWZ(r32, cb));
    bf16x8 b1 = *reinterpret_cast<const bf16x8*>((const char*)Ks + KSWZ(32 + r32, cb));
    p0 = __builtin_amdgcn_mfma_f32_32x32x16_bf16(b0, qr[d0], p0, 0, 0, 0);
    p1 = __builtin_amdgcn_mfma_f32_32x32x16_bf16(b1, qr[d0], p1, 0, 0, 0); }
}
__device__ __forceinline__ int v_st(int k, int c) { const int kk = (k & ~0xC) | ((k & 4) << 1) | ((k & 8) >> 1); return ((kk >> 3) * 4 + (c >> 5)) * 512 + ((kk & 7) * 32 + (c & 31)) * 2; }
__device__ __forceinline__ int v_rd_base(int lane) { return ((lane & 3) << 3) | (((lane >> 2) & 3) << 6) | (((lane >> 4) & 1) << 5) | (((lane >> 5) & 1) << 8); }
constexpr int v_rd_off(int d0, int ks, int half) { return d0 * 512 + ks * 4096 + half * 2048; }
template <int OFF> __device__ __forceinline__ s16x4 tr_read(int vb) {
  s16x4 r; asm volatile("ds_read_b64_tr_b16 %0, %1 offset:%2" : "=&v"(r) : "v"(vb), "i"(OFF) : "memory"); return r;
}
#define PKLH(L, H) (bf16x8){L[0], L[1], L[2], L[3], H[0], H[1], H[2], H[3]}
template <int D0> __device__ __forceinline__ void pv_one(f32x16& od, int vb, bf16x8 pa0, bf16x8 pa1, bf16x8 pa2, bf16x8 pa3) {
  const s16x4 l0 = tr_read<v_rd_off(D0, 0, 0)>(vb), h0 = tr_read<v_rd_off(D0, 0, 1)>(vb), l1 = tr_read<v_rd_off(D0, 1, 0)>(vb), h1 = tr_read<v_rd_off(D0, 1, 1)>(vb);
  const s16x4 l2 = tr_read<v_rd_off(D0, 2, 0)>(vb), h2 = tr_read<v_rd_off(D0, 2, 1)>(vb), l3 = tr_read<v_rd_off(D0, 3, 0)>(vb), h3 = tr_read<v_rd_off(D0, 3, 1)>(vb);
  asm volatile("s_waitcnt lgkmcnt(0)" ::: "memory"); SBAR();
  od = __builtin_amdgcn_mfma_f32_32x32x16_bf16(pa0, PKLH(l0, h0), od, 0, 0, 0);
  od = __builtin_amdgcn_mfma_f32_32x32x16_bf16(pa1, PKLH(l1, h1), od, 0, 0, 0);
  od = __builtin_amdgcn_mfma_f32_32x32x16_bf16(pa2, PKLH(l2, h2), od, 0, 0, 0);
  od = __builtin_amdgcn_mfma_f32_32x32x16_bf16(pa3, PKLH(l3, h3), od, 0, 0, 0);
}
__device__ __forceinline__ void pv_d0(f32x16* o, int vb, bf16x8 pa0, bf16x8 pa1, bf16x8 pa2, bf16x8 pa3) {
  pv_one<0>(o[0], vb, pa0, pa1, pa2, pa3); pv_one<1>(o[1], vb, pa0, pa1, pa2, pa3); pv_one<2>(o[2], vb, pa0, pa1, pa2, pa3); pv_one<3>(o[3], vb, pa0, pa1, pa2, pa3);
}

constexpr float THR2 = 11.5f;
__device__ __forceinline__ float softmax_rel(f32x16& p0, f32x16& p1, bool first, float& m_reg, float& l_reg, bf16x8& pa0, bf16x8& pa1, bf16x8& pa2, bf16x8& pa3) {
  float pmax = p0[0];
#pragma unroll
  for (int r = 1; r < 16; ++r) pmax = fmaxf(pmax, p0[r]);
#pragma unroll
  for (int r = 0; r < 16; ++r) pmax = fmaxf(pmax, p1[r]);
  { auto rr = __builtin_amdgcn_permlane32_swap(__float_as_uint(pmax), __float_as_uint(pmax), false, false);
    pmax = fmaxf(__uint_as_float(rr[0]), __uint_as_float(rr[1])); }
  float alpha = 1.f;
  if (__builtin_expect(first || __any(pmax > THR2), 0)) {
    const float dl = first ? pmax : fmaxf(pmax, 0.f);
    m_reg += dl; alpha = first ? 1.f : __builtin_amdgcn_exp2f(-dl);
#pragma unroll
    for (int r = 0; r < 16; ++r) { p0[r] -= dl; p1[r] -= dl; }
  }
#pragma unroll
  for (int r = 0; r < 16; ++r) p0[r] = __builtin_amdgcn_exp2f(p0[r]);
#pragma unroll
  for (int r = 0; r < 16; ++r) p1[r] = __builtin_amdgcn_exp2f(p1[r]);
  float ps = 0;
#pragma unroll
  for (int r = 0; r < 16; ++r) ps += p0[r];
#pragma unroll
  for (int r = 0; r < 16; ++r) ps += p1[r];
  { auto rr = __builtin_amdgcn_permlane32_swap(__float_as_uint(ps), __float_as_uint(ps), false, false);
    ps = __uint_as_float(rr[0]) + __uint_as_float(rr[1]); }
  l_reg = l_reg * alpha + ps;
  PK4(p0, 0, pa0); PK4(p0, 8, pa1); PK4(p1, 0, pa2); PK4(p1, 8, pa3);
  return alpha;
}
template <int OFF> __device__ __forceinline__ bf16x8 lds_rd128(int addr) { bf16x8 r; asm volatile("ds_read_b128 %0, %1 offset:%2" : "=&v"(r) : "v"(addr), "i"(OFF) : "memory"); return r; }
__device__ __forceinline__ void qkt_pipe(f32x16& p0, f32x16& p1, int kbt, int kc, const bf16x8* qr, const f32x16& z) {
  bf16x8 a0, b0, a1, b1, a2, b2, a3, b3;
#define KRD(A, B, d0) do { const int ad_ = (kc ^ ((d0) << 5)) + kbt; A = lds_rd128<0>(ad_); B = lds_rd128<8192>(ad_); } while (0)
#define KW(N) do { asm volatile("s_waitcnt lgkmcnt(" #N ")" ::: "memory"); SBAR(); } while (0)
  KRD(a0, b0, 0); KRD(a1, b1, 1); KRD(a2, b2, 2); KRD(a3, b3, 3);
  KW(6); p0 = __builtin_amdgcn_mfma_f32_32x32x16_bf16(a0, qr[0], z, 0, 0, 0);  p1 = __builtin_amdgcn_mfma_f32_32x32x16_bf16(b0, qr[0], z, 0, 0, 0);  SBAR(); KRD(a0, b0, 4);
  KW(6); p0 = __builtin_amdgcn_mfma_f32_32x32x16_bf16(a1, qr[1], p0, 0, 0, 0); p1 = __builtin_amdgcn_mfma_f32_32x32x16_bf16(b1, qr[1], p1, 0, 0, 0); SBAR(); KRD(a1, b1, 5);
  KW(6); p0 = __builtin_amdgcn_mfma_f32_32x32x16_bf16(a2, qr[2], p0, 0, 0, 0); p1 = __builtin_amdgcn_mfma_f32_32x32x16_bf16(b2, qr[2], p1, 0, 0, 0); SBAR(); KRD(a2, b2, 6);
  KW(6); p0 = __builtin_amdgcn_mfma_f32_32x32x16_bf16(a3, qr[3], p0, 0, 0, 0); p1 = __builtin_amdgcn_mfma_f32_32x32x16_bf16(b3, qr[3], p1, 0, 0, 0); SBAR(); KRD(a3, b3, 7);
  KW(6); p0 = __builtin_amdgcn_mfma_f32_32x32x16_bf16(a0, qr[4], p0, 0, 0, 0); p1 = __builtin_amdgcn_mfma_f32_32x32x16_bf16(b0, qr[4], p1, 0, 0, 0); SBAR();
  KW(4); p0 = __builtin_amdgcn_mfma_f32_32x32x16_bf16(a1, qr[5], p0, 0, 0, 0); p1 = __builtin_amdgcn_mfma_f32_32x32x16_bf16(b1, qr[5], p1, 0, 0, 0); SBAR();
  KW(2); p0 = __builtin_amdgcn_mfma_f32_32x32x16_bf16(a2, qr[6], p0, 0, 0, 0); p1 = __builtin_amdgcn_mfma_f32_32x32x16_bf16(b2, qr[6], p1, 0, 0, 0); SBAR();
  KW(0); p0 = __builtin_amdgcn_mfma_f32_32x32x16_bf16(a3, qr[7], p0, 0, 0, 0); p1 = __builtin_amdgcn_mfma_f32_32x32x16_bf16(b3, qr[7], p1, 0, 0, 0);
#undef KRD
#undef KW
}
struct VFrag { s16x4 l0, h0, l1, h1, l2, h2, l3, h3; };
template <int D0> __device__ __forceinline__ void vf_read(VFrag& f, int vb) {
  f.l0 = tr_read<v_rd_off(D0, 0, 0)>(vb); f.h0 = tr_read<v_rd_off(D0, 0, 1)>(vb); f.l1 = tr_read<v_rd_off(D0, 1, 0)>(vb); f.h1 = tr_read<v_rd_off(D0, 1, 1)>(vb);
  f.l2 = tr_read<v_rd_off(D0, 2, 0)>(vb); f.h2 = tr_read<v_rd_off(D0, 2, 1)>(vb); f.l3 = tr_read<v_rd_off(D0, 3, 0)>(vb); f.h3 = tr_read<v_rd_off(D0, 3, 1)>(vb);
}
__device__ __forceinline__ void vf_mma(f32x16& od, const VFrag& f, bf16x8 pa0, bf16x8 pa1, bf16x8 pa2, bf16x8 pa3) {
  od = __builtin_amdgcn_mfma_f32_32x32x16_bf16(pa0, PKLH(f.l0, f.h0), od, 0, 0, 0);
  od = __builtin_amdgcn_mfma_f32_32x32x16_bf16(pa1, PKLH(f.l1, f.h1), od, 0, 0, 0);
  od = __builtin_amdgcn_mfma_f32_32x32x16_bf16(pa2, PKLH(f.l2, f.h2), od, 0, 0, 0);
  od = __builtin_amdgcn_mfma_f32_32x32x16_bf16(pa3, PKLH(f.l3, f.h3), od, 0, 0, 0);
}
#define VF_WAIT(N) do { asm volatile("s_waitcnt lgkmcnt(" #N ")" ::: "memory"); SBAR(); } while (0)
__device__ __forceinline__ void pv8(f32x16* o, int vb, bf16x8 pa0, bf16x8 pa1, bf16x8 pa2, bf16x8 pa3) {
  VFrag fa, fb; const int vb2 = vb + 16384;
  vf_read<0>(fa, vb);
  vf_read<1>(fb, vb);  VF_WAIT(8); vf_mma(o[0], fa, pa0, pa1, pa2, pa3); SBAR();
  vf_read<2>(fa, vb);  VF_WAIT(8); vf_mma(o[1], fb, pa0, pa1, pa2, pa3); SBAR();
  vf_read<3>(fb, vb);  VF_WAIT(8); vf_mma(o[2], fa, pa0, pa1, pa2, pa3); SBAR();
  vf_read<0>(fa, vb2); VF_WAIT(8); vf_mma(o[3], fb, pa0, pa1, pa2, pa3); SBAR();
  vf_read<1>(fb, vb2); VF_WAIT(8); vf_mma(o[4], fa, pa0, pa1, pa2, pa3); SBAR();
  vf_read<2>(fa, vb2); VF_WAIT(8); vf_mma(o[5], fb, pa0, pa1, pa2, pa3); SBAR();
  vf_read<3>(fb, vb2); VF_WAIT(8); vf_mma(o[6], fa, pa0, pa1, pa2, pa3); SBAR();
  VF_WAIT(0); vf_mma(o[7], fb, pa0, pa1, pa2, pa3);
}

constexpr int A_LDS_K = 0, A_LDS_V = 49152, A_LDS_WS = 147456;
constexpr long TSTRIDE = 64L * LDP * 2;
__device__ __forceinline__ void glds16(const void* gsrc, unsigned lds_dst) { unsigned keep;
  asm volatile("s_mov_b32 %0, m0\n\ts_mov_b32 m0, %2\n\ts_nop 0\n\tglobal_load_lds_dwordx4 %1, off ; A256DMA\n\ts_mov_b32 m0, %0" : "=&s"(keep) : "v"(gsrc), "s"(lds_dst) : "memory"); }
#define A_WAITBAR(N) asm volatile("s_waitcnt vmcnt(" #N ") lgkmcnt(0) ; A256BAR\n\ts_barrier" ::: "memory")
template <int mode>
__device__ __forceinline__ void attn256_unit(const hbf* __restrict__ Qb, const hbf* __restrict__ Kh, const hbf* __restrict__ Vh, int seq, char* lds, int tid,
                                             float* stash, unsigned short* mixo, float lam, const float* __restrict__ sublnw) {
  asm volatile("" : "+v"(tid));
  const int wid = __builtin_amdgcn_readfirstlane(tid >> 6), lane = tid & 63, r32 = lane & 31, hi = lane >> 5;
  const unsigned lds0 = (unsigned)(uintptr_t)lds;
  float* ws = (float*)(lds + A_LDS_WS) + wid * 64; float* li_l = ws; float* al_l = ws + 32;
  unsigned koff[2], voff[4];
#pragma unroll
  for (int i = 0; i < 2; ++i) { const int row = (wid * 2 + i) * 4 + (lane >> 4), chunk = (lane & 15) ^ (((row & 7) << 1) | ((row >> 3) & 1)); koff[i] = (unsigned)(row * (LDP * 2) + chunk * 16); }
#pragma unroll
  for (int i = 0; i < 4; ++i) { const int q = (wid & 3) * 4 + i, subtile = q * 2 + (lane >> 5), kk = (subtile >> 2) * 8 + ((lane & 31) >> 2);
    const int k = (kk & ~0xC) | ((kk & 4) << 1) | ((kk & 8) >> 1), col = (subtile & 3) * 32 + (lane & 3) * 8;
    voff[i] = (unsigned)(k * (LDP * 2) + ((wid >> 2) * 128 + col) * 2); }
  const char* Kb = (const char*)Kh; const char* Vb = (const char*)Vh;
  const unsigned kdst = lds0 + A_LDS_K + wid * 2048, vdst = lds0 + A_LDS_V + (wid >> 2) * 16384 + (wid & 3) * 4096;
#define RFL(x) ((unsigned)__builtin_amdgcn_readfirstlane((int)(x)))
#define DMA_K(t, sl) do { const char* b_ = Kb + (size_t)(t) * TSTRIDE; const unsigned d_ = RFL(kdst + (sl) * 16384); glds16(b_ + koff[0], d_); glds16(b_ + koff[1], d_ + 1024); } while (0)
#define DMA_V(t, sl) do { const char* b_ = Vb + (size_t)(t) * TSTRIDE; const unsigned d_ = RFL(vdst + (sl) * 32768); glds16(b_ + voff[0], d_); glds16(b_ + voff[1], d_ + 1024); glds16(b_ + voff[2], d_ + 2048); glds16(b_ + voff[3], d_ + 3072); } while (0)
  bf16x8 qr[8];
  { const hbf* Qw = Qb + (long)(wid * QBLK + r32) * LDQ + hi * 8;
#pragma unroll
    for (int d0 = 0; d0 < 8; ++d0) qr[d0] = *reinterpret_cast<const bf16x8*>(Qw + d0 * 16); }
  asm volatile("" : "+v"(qr[0]), "+v"(qr[1]), "+v"(qr[2]), "+v"(qr[3]), "+v"(qr[4]), "+v"(qr[5]), "+v"(qr[6]), "+v"(qr[7]));
  DMA_K(0, 0); DMA_V(0, 0); DMA_K(1, 1); DMA_V(1, 1);
  float m_reg = 0.f, l_reg = 0; f32x16 o[8] = {};
  const int vb0 = (int)(lds0 + A_LDS_V) + v_rd_base(lane);
  const int kb0 = (int)(lds0 + A_LDS_K) + r32 * 256, kc = (hi << 4) ^ ((((r32 & 7) << 1) | ((r32 >> 3) & 1)) << 4);
  const int NT = seq / KVBLK;
#define RESC(a) do { if (__any((a) < 1.f)) { if (hi == 0) al_l[r32] = (a); asm volatile("s_waitcnt lgkmcnt(0)" ::: "memory"); \
    _Pragma("unroll") for (int d = 0; d < 8; ++d) _Pragma("unroll") for (int r = 0; r < 16; ++r) o[d][r] *= al_l[crow(r, hi)]; } } while (0)
  A_WAITBAR(6);
  if (wid >= 4) asm volatile("s_barrier" ::: "memory");
  int s0 = 0, s1 = 1, s2 = 2;
  for (int j = 0; j < NT; ++j) {
    const bool more = j + 2 < NT;
    if (more) DMA_K(j + 2, s2);
    f32x16 p0, p1; bf16x8 pa0, pa1, pa2, pa3;
    __builtin_amdgcn_s_setprio(2);
    { f32x16 negm;
#pragma unroll
      for (int r = 0; r < 16; ++r) negm[r] = -m_reg;
      qkt_pipe(p0, p1, kb0 + s0 * 16384, kc, qr, negm); }
    const float alpha = softmax_rel(p0, p1, j == 0, m_reg, l_reg, pa0, pa1, pa2, pa3);
    RESC(alpha);
    __builtin_amdgcn_s_setprio(0);
    if (more) A_WAITBAR(6); else A_WAITBAR(0);
    if (more) DMA_V(j + 2, s2);
    pv8(o, vb0 + s0 * 32768, pa0, pa1, pa2, pa3);
    if (more) A_WAITBAR(6); else A_WAITBAR(0);
    { const int t_ = s0; s0 = s1; s1 = s2; s2 = t_; }
  }
  if (wid < 4) asm volatile("s_barrier" ::: "memory");
  if (hi == 0) li_l[r32] = l_reg; asm volatile("s_waitcnt lgkmcnt(0)" ::: "memory");
  float rli[16];
#pragma unroll
  for (int r = 0; r < 16; ++r) rli[r] = __builtin_amdgcn_rcpf(li_l[crow(r, hi)]);
  typedef float f32x4_t __attribute__((ext_vector_type(4)));
  f32x4_t* st4 = (f32x4_t*)stash + (size_t)wid * 2048 + lane;
  if constexpr (mode == 0) {
#pragma unroll
    for (int d0 = 0; d0 < 8; ++d0)
#pragma unroll
      for (int q = 0; q < 4; ++q) st4[(d0 * 4 + q) * 64] = (f32x4_t){o[d0][4 * q] * rli[4 * q], o[d0][4 * q + 1] * rli[4 * q + 1], o[d0][4 * q + 2] * rli[4 * q + 2], o[d0][4 * q + 3] * rli[4 * q + 3]};
  } else {
    typedef __attribute__((address_space(3))) float lds_f32;
    lds_f32* rs = (lds_f32*)(lds0 + A_LDS_WS + wid * 256 + 128);
    if (hi == 0) rs[r32] = 0.f;
    float ss[16];
#pragma unroll
    for (int r = 0; r < 16; ++r) ss[r] = 0.f;
#pragma unroll
    for (int d0 = 0; d0 < 8; ++d0) {
      f32x4_t a0, a1, a2, a3;
      { typedef unsigned long long u64; const u64* p0 = (const u64*)&st4[(d0 * 4 + 0) * 64]; const u64* p1 = (const u64*)&st4[(d0 * 4 + 1) * 64]; const u64* p2 = (const u64*)&st4[(d0 * 4 + 2) * 64]; const u64* p3 = (const u64*)&st4[(d0 * 4 + 3) * 64];
        const u64 x0 = __hip_atomic_load(p0, __ATOMIC_RELAXED, __HIP_MEMORY_SCOPE_AGENT), x1 = __hip_atomic_load(p0 + 1, __ATOMIC_RELAXED, __HIP_MEMORY_SCOPE_AGENT);
        const u64 y0 = __hip_atomic_load(p1, __ATOMIC_RELAXED, __HIP_MEMORY_SCOPE_AGENT), y1 = __hip_atomic_load(p1 + 1, __ATOMIC_RELAXED, __HIP_MEMORY_SCOPE_AGENT);
        const u64 z0 = __hip_atomic_load(p2, __ATOMIC_RELAXED, __HIP_MEMORY_SCOPE_AGENT), z1 = __hip_atomic_load(p2 + 1, __ATOMIC_RELAXED, __HIP_MEMORY_SCOPE_AGENT);
        const u64 w0 = __hip_atomic_load(p3, __ATOMIC_RELAXED, __HIP_MEMORY_SCOPE_AGENT), w1 = __hip_atomic_load(p3 + 1, __ATOMIC_RELAXED, __HIP_MEMORY_SCOPE_AGENT);
        a0 = (f32x4_t){__uint_as_float((unsigned)x0), __uint_as_float((unsigned)(x0 >> 32)), __uint_as_float((unsigned)x1), __uint_as_float((unsigned)(x1 >> 32))};
        a1 = (f32x4_t){__uint_as_float((unsigned)y0), __uint_as_float((unsigned)(y0 >> 32)), __uint_as_float((unsigned)y1), __uint_as_float((unsigned)(y1 >> 32))};
        a2 = (f32x4_t){__uint_as_float((unsigned)z0), __uint_as_float((unsigned)(z0 >> 32)), __uint_as_float((unsigned)z1), __uint_as_float((unsigned)(z1 >> 32))};
        a3 = (f32x4_t){__uint_as_float((unsigned)w0), __uint_as_float((unsigned)(w0 >> 32)), __uint_as_float((unsigned)w1), __uint_as_float((unsigned)(w1 >> 32))}; }
#pragma unroll
      for (int k = 0; k < 4; ++k) {
        float d;
        d = a0[k] - lam * (o[d0][k] * rli[k]);           o[d0][k] = d;      ss[k] += d * d;
        d = a1[k] - lam * (o[d0][4 + k] * rli[4 + k]);   o[d0][4 + k] = d;  ss[4 + k] += d * d;
        d = a2[k] - lam * (o[d0][8 + k] * rli[8 + k]);   o[d0][8 + k] = d;  ss[8 + k] += d * d;
        d = a3[k] - lam * (o[d0][12 + k] * rli[12 + k]); o[d0][12 + k] = d; ss[12 + k] += d * d; }
      asm volatile("" : "+v"(o[d0]) :: "memory");
    }
    asm volatile("s_waitcnt lgkmcnt(0)" ::: "memory");
#pragma unroll
    for (int r = 0; r < 16; ++r) __hip_atomic_fetch_add(rs + crow(r, hi), ss[r], __ATOMIC_RELAXED, __HIP_MEMORY_SCOPE_WORKGROUP);
    asm volatile("s_waitcnt lgkmcnt(0)" ::: "memory");
#pragma unroll
    for (int r = 0; r < 16; ++r) ss[r] = (1.0f - LAMBDA_INIT) / sqrtf(rs[crow(r, hi)] * (1.0f / 256.0f) + RMS_EPS);
    unsigned short* stg = (unsigned short*)(lds + wid * 16384);
#pragma unroll
    for (int d0 = 0; d0 < 8; ++d0) { const float sw = sublnw[d0 * 32 + r32];
#pragma unroll
      for (int r = 0; r < 16; ++r) stg[crow(r, hi) * 256 + d0 * 32 + r32] = (unsigned short)(cvtpk(o[d0][r] * ss[r] * sw, 0.f) & 0xffffu); }
    asm volatile("s_waitcnt lgkmcnt(0)" ::: "memory");
    unsigned short* Mw = mixo + (size_t)(wid * QBLK) * DM;
#pragma unroll
    for (int i = 0; i < 16; ++i) { const int p = i * 64 + lane, row = p >> 5, ch = p & 31;
      const u32x4 v = *(const u32x4*)(stg + row * 256 + ch * 8); *(u32x4*)(Mw + (size_t)row * DM + ch * 8) = v; }
    asm volatile("s_waitcnt lgkmcnt(0)\n\ts_barrier" ::: "memory");
  }
#undef RESC
#undef DMA_K
#undef DMA_V
#undef RFL
}
}

constexpr int NWAVES = 8;
constexpr size_t MiB = 1u << 20;
constexpr size_t WS_CTL = 0, CTL_ZERO_BYTES = 1 * MiB;
constexpr size_t WS_PAR = 1 * MiB;
constexpr int PAR_DECF = 0, PAR_DECB = 8, PAR_LQ1 = 16, PAR_LK1 = 144, PAR_LQ2 = 272, PAR_LK2 = 400, PAR_SUBLN = 528, PAR_GNW = 784, PAR_LN1G = 2832, PAR_LN1B = 6928, PAR_LN2G = 11024, PAR_LN2B = 15120, PAR_LAM = 19216, PAR_END = 19232;
constexpr size_t WS_TABR = 2 * MiB;
constexpr size_t WS_TABD = 10 * MiB;
constexpr size_t WS_WIN = 12 * MiB;
constexpr size_t WS_WOUT = 108 * MiB;
constexpr size_t WS_WGU = 140 * MiB;
constexpr size_t WS_XQ = 228 * MiB;
constexpr size_t WS_SA = 292 * MiB;
constexpr size_t WS_WD = 312 * MiB;
constexpr size_t WS_XB = 398 * MiB;
constexpr size_t WS_PROJ = 526 * MiB;
constexpr size_t WS_OS = 910 * MiB;
constexpr size_t WS_END = 1166 * MiB;
static_assert(WS_WIN + (size_t)INC * DM * 2 <= WS_WOUT && WS_WOUT + (size_t)DM * DM * 2 <= WS_WGU && WS_WGU + (size_t)NGU * DM * 2 <= WS_WD && WS_WD + (size_t)DM * DFF * 2 <= WS_XB, "ws map");
static_assert(WS_XB + (size_t)TOK * DM * 2 <= WS_PROJ && WS_PROJ + (size_t)TOK * INC * 2 <= WS_OS && WS_OS + (size_t)2 * TOK * 2048 * 4 <= WS_END, "ws map");
constexpr int CW_BAR = 4096;
constexpr int CW_CMAX = 32768;
static_assert(WS_WGU + (size_t)NGU * DM <= WS_XQ && WS_XQ + (size_t)TOK * DM <= WS_SA && WS_SA + (size_t)TOK * 4 <= WS_WD && (CW_CMAX + 2 * DFF) * 4 <= (int)CTL_ZERO_BYTES, "ws map (int8 operands)");
constexpr int RING_BYTES = 131072;
constexpr int LDSCTL_OFF = 147456 + 2048, MISC_OFF = LDSCTL_OFF + 320;
constexpr int LDS_BYTES = 163840;

#define LAS __attribute__((address_space(3)))
typedef unsigned short bf16;
typedef unsigned v4u __attribute__((ext_vector_type(4)));
typedef unsigned v2u __attribute__((ext_vector_type(2)));
typedef float f32x4 __attribute__((ext_vector_type(4)));
typedef int i32x4 __attribute__((ext_vector_type(4)));
typedef int i32x8 __attribute__((ext_vector_type(8)));
typedef float f32x2 __attribute__((ext_vector_type(2)));
#define LDS_WAIT() asm volatile("s_waitcnt lgkmcnt(0)" ::: "memory")
__device__ __forceinline__ unsigned f2bf(float f) { unsigned u = __builtin_bit_cast(unsigned, f); return (u + 0x7fffu + ((u >> 16) & 1u)) >> 16; }
__device__ __forceinline__ unsigned pk2(float lo, float hi) { return f2bf(lo) | (f2bf(hi) << 16); }
__device__ __forceinline__ float bflo(unsigned w) { return __uint_as_float(w << 16); }
__device__ __forceinline__ float bfhi(unsigned w) { return __uint_as_float(w & 0xffff0000u); }

#define XB_TMO      128
#define XB_XCNT(j)  (256  + 64 * (j))
#define XB_XSUB(j)  (1280 + 64 * (j))
#define XB_XGEN(j)  (2304 + 64 * (j))
#define XB_TOP      3328
#define XB_TOPGEN   3392
#define XCD_BAR_WORDS 3456
#define XB_SPIN_CAP (1u << 18)
__device__ __forceinline__ unsigned xb_ld(unsigned* p)              { asm volatile("" : "+v"(p)); return __hip_atomic_load(p, __ATOMIC_RELAXED, __HIP_MEMORY_SCOPE_AGENT); }
__device__ __forceinline__ unsigned xb_add(unsigned* p, unsigned v) { asm volatile("" : "+v"(p)); return __hip_atomic_fetch_add(p, v, __ATOMIC_RELAXED, __HIP_MEMORY_SCOPE_AGENT); }
__device__ __forceinline__ unsigned xb_xcc_id() { return (unsigned)__builtin_amdgcn_s_getreg((3 << 11) | 20) & 0xFu; }
#define XB_SPIN(cond, bar) do { unsigned _sp = 0; while (cond) { __builtin_amdgcn_s_sleep(1); \
    if ((++_sp & 255u) == 0u) { if (xb_ld(&(bar)[XB_TMO])) break; if (_sp > XB_SPIN_CAP) { (void)xb_add(&(bar)[XB_TMO], 1u); break; } } } } while (0)
struct XcdBarrier { unsigned* bar; unsigned x; volatile LAS unsigned* st; };
__device__ __forceinline__ XcdBarrier xcd_barrier_post(unsigned* bar, volatile LAS unsigned* st, int tid) {
    XcdBarrier b; b.bar = bar; b.x = xb_xcc_id(); b.st = st;
    if (tid == 0) (void)xb_add(&bar[XB_XCNT(b.x)], 1u);
    return b;
}
__device__ __forceinline__ void xcd_barrier_complete(unsigned* bar, unsigned x, unsigned& nloc, unsigned& nx) {
    const unsigned G = gridDim.x * gridDim.y * gridDim.z;
    unsigned sum, cnt, mine, sp = 0u;
    for (;;) {
        sum = 0u; cnt = 0u; mine = 0u;
#pragma unroll
        for (unsigned j = 0; j < 16; ++j) { const unsigned c = xb_ld(&bar[XB_XCNT(j)]); sum += c; cnt += (c > 0u) ? 1u : 0u; mine = (j == x) ? c : mine; }
        if (sum == G) break;
        __builtin_amdgcn_s_sleep(1);
        if ((++sp & 255u) == 0u) { if (xb_ld(&bar[XB_TMO])) break; if (sp > XB_SPIN_CAP) { (void)xb_add(&bar[XB_TMO], 1u); break; } }
    }
    nloc = mine > 0u ? mine : 1u; nx = cnt > 0u ? cnt : 1u;
}
__device__ __forceinline__ void xcd_barrier(const XcdBarrier& b, int tid) {
    asm volatile("s_waitcnt vmcnt(0)" ::: "memory");
    __syncthreads();
    if (tid == 0) {
        unsigned* bar = b.bar;
        __builtin_amdgcn_s_waitcnt(0);
        unsigned nloc = b.st[0], nx = b.st[1];
        if (nloc == 0u) { xcd_barrier_complete(bar, b.x, nloc, nx); b.st[0] = nloc; b.st[1] = nx; }
        const unsigned old = xb_add(&bar[XB_XSUB(b.x)], 1u);
        const unsigned gen = old / nloc;
        if (old + 1u == (gen + 1u) * nloc) {
            __builtin_amdgcn_fence(__ATOMIC_RELEASE, "agent");
            asm volatile("s_waitcnt vmcnt(0)" ::: "memory");
            const unsigned og = xb_add(&bar[XB_TOP], 1u);
            const unsigned tg = og / nx;
            if (og + 1u == (tg + 1u) * nx) xb_add(&bar[XB_TOPGEN], 1u);
            else XB_SPIN(xb_ld(&bar[XB_TOPGEN]) == tg, bar);
            __builtin_amdgcn_fence(__ATOMIC_ACQUIRE, "agent");
            xb_add(&bar[XB_XGEN(b.x)], 1u);
            asm volatile("s_waitcnt vmcnt(0)" ::: "memory");
        } else {
            XB_SPIN(xb_ld(&bar[XB_XGEN(b.x)]) == gen, bar);
            __builtin_amdgcn_fence(__ATOMIC_ACQUIRE, "agent");
            asm volatile("s_waitcnt vmcnt(0)" ::: "memory");
        }
    }
    __syncthreads();
}

__device__ __forceinline__ float wave_sum(float v, int lane) {
#pragma unroll
    for (int o = 1; o < 64; o <<= 1) v += __int_as_float(__builtin_amdgcn_ds_bpermute((lane ^ o) << 2, __float_as_int(v)));
    return v;
}

__device__ __forceinline__ float wave_max(float v, int lane) {
#pragma unroll
    for (int o = 1; o < 64; o <<= 1) v = fmaxf(v, __int_as_float(__builtin_amdgcn_ds_bpermute((lane ^ o) << 2, __float_as_int(v))));
    return v;
}
__device__ __forceinline__ unsigned pk_i8x4(float a, float b, float c, float d) {
    const unsigned u0 = __float_as_uint(a + 12582912.f), u1 = __float_as_uint(b + 12582912.f), u2 = __float_as_uint(c + 12582912.f), u3 = __float_as_uint(d + 12582912.f);
    return (u0 & 255u) | ((u1 & 255u) << 8) | ((u2 & 255u) << 16) | (u3 << 24);
}

__host__ __device__ __forceinline__ int rowmap_in(int n) {
    if (n < 2048) { const int d = n & 127; const int p = (d < 64) ? (8 * (d >> 2) + (d & 3)) : (8 * ((d - 64) >> 2) + 4 + (d & 3)); return (n & ~127) + p; }
    if (n >= 6144 && n < 10240) { const int d = n & 127; if (d < 32) { const int p = (d < 16) ? (8 * (d >> 2) + (d & 3)) : (8 * ((d - 16) >> 2) + 4 + (d & 3)); return (n & ~127) + p; } }
    return n;
}
__device__ __forceinline__ void p0_transpose_item(const float* W, int K, int N, bf16* WT, int mode, LAS float* scr, int item, int lane, const unsigned* cmax = nullptr) {
    const int nblk = N / 32, kb = item / nblk, nb = item % nblk, k0 = 64 * kb, n0 = 32 * nb;
    const int rbase = (mode == 0 || mode == 3 || mode == 4) ? n0 : (n0 + (n0 >> 7) * 128 + ((mode == 2 || mode == 6) ? 128 : 0));
    float tv[32];
#pragma unroll
    for (int i = 0; i < 32; ++i) { const int kk = 2 * i + (lane >> 5); tv[i] = W[(size_t)(k0 + kk) * N + n0 + (lane & 31)]; }
#pragma unroll
    for (int i = 0; i < 32; ++i) { const int kk = 2 * i + (lane >> 5); scr[kk * 33 + (lane & 31)] = tv[i]; }
    LDS_WAIT(); asm volatile("" ::: "memory");
    const int c = lane & 7;
#pragma unroll
    for (int j = 0; j < 4; ++j) { const int n = (lane >> 3) + 8 * j; const LAS float* s = scr + (8 * c) * 33 + n;
        v4u o; o.x = pk2(s[0 * 33], s[1 * 33]); o.y = pk2(s[2 * 33], s[3 * 33]); o.z = pk2(s[4 * 33], s[5 * 33]); o.w = pk2(s[6 * 33], s[7 * 33]);
        if (mode == 4) {
            unsigned char* rowb = (unsigned char*)WT + (size_t)(n0 + n) * pg8::HROWB;
            if (k0 < pg8::H16) *(v4u*)(rowb + (size_t)(k0 + 8 * c) * 2) = o;
            else { float q[8];
#pragma unroll
                   for (int i = 0; i < 8; ++i) q[i] = __builtin_amdgcn_fmed3f(s[i * 33] * 128.f, -448.f, 448.f);
                   int w0 = __builtin_amdgcn_cvt_pk_fp8_f32(q[0], q[1], 0, false); w0 = __builtin_amdgcn_cvt_pk_fp8_f32(q[2], q[3], w0, true);
                   int w1 = __builtin_amdgcn_cvt_pk_fp8_f32(q[4], q[5], 0, false); w1 = __builtin_amdgcn_cvt_pk_fp8_f32(q[6], q[7], w1, true);
                   v2u o8; o8.x = (unsigned)w0; o8.y = (unsigned)w1; *(v2u*)(rowb + pg8::H16 * 2 + (k0 - pg8::H16) + 8 * c) = o8; }
            continue; }
        if (mode >= 5) { const float sc = 127.f / fmaxf(__uint_as_float(cmax[(mode == 6 ? N : 0) + n0 + n]), 1e-30f);
            v2u o8; o8.x = pk_i8x4(s[0 * 33] * sc, s[1 * 33] * sc, s[2 * 33] * sc, s[3 * 33] * sc); o8.y = pk_i8x4(s[4 * 33] * sc, s[5 * 33] * sc, s[6 * 33] * sc, s[7 * 33] * sc);
            *(v2u*)((unsigned char*)WT + (size_t)(rbase + n) * K + k0 + 8 * c) = o8; continue; }
        const int drow = (mode == 3) ? rowmap_in(n0 + n) : (rbase + n);
        *(v4u*)(WT + (size_t)drow * K + k0 + 8 * c) = o; }
    LDS_WAIT(); asm volatile("" ::: "memory");
}
__device__ __forceinline__ void sincos_d(double a, float& s, float& c) {
    const double q = rint(a * 0.63661977236758134308);
    double r = fma(-q, 1.57079632679489655800e+00, a); r = fma(-q, 6.12323399573676603587e-17, r);
    const double r2 = r * r;
    const double sp = r * (1.0 + r2 * (-1.0 / 6 + r2 * (1.0 / 120 + r2 * (-1.0 / 5040 + r2 * (1.0 / 362880 + r2 * (-1.0 / 39916800 + r2 * (1.0 / 6227020800.0)))))));
    const double cp = 1.0 + r2 * (-0.5 + r2 * (1.0 / 24 + r2 * (-1.0 / 720 + r2 * (1.0 / 40320 + r2 * (-1.0 / 3628800 + r2 * (1.0 / 479001600.0 + r2 * (-1.0 / 87178291200.0)))))));
    const int qi = (int)q & 3;
    double ss = (qi & 1) ? cp : sp, cc = (qi & 1) ? sp : cp;
    if (qi == 1) cc = -cc;
    if (qi == 2) { ss = -ss; cc = -cc; }
    if (qi == 3) ss = -ss;
    s = (float)ss; c = (float)cc;
}

__device__ __forceinline__ int lane_id_v() { int r; asm volatile("v_mbcnt_lo_u32_b32 %0, -1, 0\n\tv_mbcnt_hi_u32_b32 %0, -1, %0" : "=v"(r)); return r; }
struct Args { const float* in[19]; float* out; unsigned char* ws; };

__global__ void __launch_bounds__(NWAVES * 64, 2) mega_fwd(Args args) {
    extern __shared__ __attribute__((aligned(16))) unsigned char lds[];
    LAS unsigned char* L = (LAS unsigned char*)lds;
    volatile LAS unsigned* MISC = (volatile LAS unsigned*)(L + MISC_OFF);
    const int G = gridDim.x, bx = blockIdx.x;
    const int NGW = G * NWAVES; const long NGT = (long)G * 512;
    const int wave_s = __builtin_amdgcn_readfirstlane((int)threadIdx.x >> 6);
#define LANE_ID() lane_id_v()
#define CUR_TID() (wave_s * 64 + LANE_ID())
#define PHASE_IDS() int wv_ = wave_s; asm volatile("" : "+s"(wv_)); const int wave = wv_; int tid = wave * 64 + LANE_ID(); asm volatile("" : "+v"(tid)); const int lane = tid & 63; (void)lane; \
    const int gw = bx * NWAVES + wave; const long gtid = (long)bx * 512 + tid; (void)gw; (void)gtid
#define GRID_BAR() xcd_barrier(bar, CUR_TID())
    unsigned char* ws = args.ws;
    unsigned* ctl = (unsigned*)(ws + WS_CTL);
    for (int u = threadIdx.x; u < (LDS_BYTES - LDSCTL_OFF) / 4; u += NWAVES * 64) ((LAS unsigned*)(L + LDSCTL_OFF))[u] = 0u;
    __syncthreads();
    XcdBarrier bar = xcd_barrier_post(ctl + CW_BAR, MISC + 8, (int)threadIdx.x);

    const float* PAR = (const float*)(ws + WS_PAR);
    const float* dec_f = PAR + PAR_DECF; const float* dec_b = PAR + PAR_DECB; const float* gn_w = PAR + PAR_GNW;
    const float* lq1 = PAR + PAR_LQ1; const float* lk1 = PAR + PAR_LK1; const float* lq2 = PAR + PAR_LQ2; const float* lk2 = PAR + PAR_LK2;
    const float* subln_w = PAR + PAR_SUBLN; const float* ln1_g = PAR + PAR_LN1G; const float* ln1_b = PAR + PAR_LN1B; const float* ln2_g = PAR + PAR_LN2G; const float* ln2_b = PAR + PAR_LN2B;
    bf16* Win_t = (bf16*)(ws + WS_WIN); bf16* Wout_t = (bf16*)(ws + WS_WOUT); bf16* Wgu_t = (bf16*)(ws + WS_WGU); bf16* Wd_t = (bf16*)(ws + WS_WD);
    bf16* XB = (bf16*)(ws + WS_XB); bf16* PROJ = (bf16*)(ws + WS_PROJ); bf16* HB = (bf16*)(ws + WS_PROJ); float* OS = (float*)(ws + WS_OS); bf16* KVB = (bf16*)(ws + WS_OS); bf16* SB = (bf16*)(ws + WS_OS + 128 * MiB); bf16* MP = (bf16*)(ws + WS_OS);
    f32x2* tabR = (f32x2*)(ws + WS_TABR); f32x2* tabD = (f32x2*)(ws + WS_TABD);
    unsigned* XQ = (unsigned*)(ws + WS_XQ); float* SAq = (float*)(ws + WS_SA);

    {
        PHASE_IDS();
        const float* w_in = args.in[2]; const float* w_out = args.in[11]; const float* w_gate = args.in[14]; const float* w_up = args.in[15]; const float* w_down = args.in[16];
        { float* P = (float*)(ws + WS_PAR);
          if (bx == 0) {
            for (int i = tid; i < 8; i += 512) { P[PAR_DECF + i] = args.in[3][i]; P[PAR_DECB + i] = args.in[4][i]; }
            for (int i = tid; i < 128; i += 512) { P[PAR_LQ1 + i] = args.in[6][i]; P[PAR_LK1 + i] = args.in[7][i]; P[PAR_LQ2 + i] = args.in[8][i]; P[PAR_LK2 + i] = args.in[9][i]; }
            for (int i = tid; i < 256; i += 512) P[PAR_SUBLN + i] = args.in[10][i];
            for (int i = tid; i < 2048; i += 512) P[PAR_GNW + i] = args.in[5][i];
            for (int i = tid; i < 4096; i += 512) { P[PAR_LN1G + i] = args.in[12][i]; P[PAR_LN1B + i] = args.in[13][i]; P[PAR_LN2G + i] = args.in[17][i]; P[PAR_LN2B + i] = args.in[18][i]; }
            if (wave == 0) {
              float a = args.in[6][lane] * args.in[7][lane] + args.in[6][lane + 64] * args.in[7][lane + 64], b = args.in[8][lane] * args.in[9][lane] + args.in[8][lane + 64] * args.in[9][lane + 64];
              a = wave_sum(a, lane); b = wave_sum(b, lane); if (lane == 0) P[PAR_LAM] = __expf(a) - __expf(b) + LAMBDA_INIT; }
          } }
        LAS float* scr = (LAS float*)(L + wave * 16384);
        constexpr int I_IN = (DM / 64) * (INC / 32), I_OUT = (DM / 64) * (DM / 32), I_G = (DM / 64) * (DFF / 32), I_D = (DFF / 64) * (DM / 32);
        constexpr int NITEMS = I_IN + I_OUT + I_D;
        for (int it = gw; it < NITEMS; it += NGW) {
            int r = it;
            if (r < I_IN) { p0_transpose_item(w_in, DM, INC, Win_t, 3, scr, r, lane); continue; } r -= I_IN;
            if (r < I_OUT) { p0_transpose_item(w_out, DM, DM, Wout_t, 0, scr, r, lane); continue; } r -= I_OUT;
            p0_transpose_item(w_down, DFF, DM, Wd_t, 4, scr, r, lane);
        }
        for (int it = gw; it < 2 * 16 * 43; it += NGW) { const int mat = it / 688, r = it % 688, kb = r / 43, cb = r % 43;
            const float* Wp = (mat ? w_up : w_gate) + (size_t)(kb * 256) * DFF + cb * 256 + 4 * lane;
            f32x4 mx = {0.f, 0.f, 0.f, 0.f};
            for (int i0 = 0; i0 < 256; i0 += 16) { f32x4 t[16];
#pragma unroll
                for (int i = 0; i < 16; ++i) t[i] = *(const f32x4*)(Wp + (size_t)(i0 + i) * DFF);
#pragma unroll
                for (int i = 0; i < 16; ++i) { mx[0] = fmaxf(mx[0], fabsf(t[i][0])); mx[1] = fmaxf(mx[1], fabsf(t[i][1])); mx[2] = fmaxf(mx[2], fabsf(t[i][2])); mx[3] = fmaxf(mx[3], fabsf(t[i][3])); } }
            unsigned* cmp = ctl + CW_CMAX + mat * DFF + cb * 256 + 4 * lane;
#pragma unroll
            for (int c = 0; c < 4; ++c) __hip_atomic_fetch_max(cmp + c, __float_as_uint(mx[c]), __ATOMIC_RELAXED, __HIP_MEMORY_SCOPE_AGENT); }
        for (long e = gtid; e < 16384L * 64; e += NGT) { const int pos = (int)(e >> 6), i = (int)(e & 63);
            const double inv = exp(-(double)i * (9.210340371976184 / 64.0));
            float s, c; sincos_d((double)pos * inv, s, c); tabR[e] = (f32x2){c, s}; }
        for (long e = gtid; e < 16384L * 16; e += NGT) { const int pos = (int)(e >> 4), i = (int)(e & 15);
            const double inv = exp(-(double)i * (13.122363377404328 / 16.0));
            float s, c; sincos_d((double)pos * inv, s, c); tabD[e] = (f32x2){c, s}; }
    }
    GRID_BAR();
    {
        PHASE_IDS();
        const float* w_gate = args.in[14]; const float* w_up = args.in[15];
        LAS float* scr = (LAS float*)(L + wave * 16384);
        constexpr int I_G = (DM / 64) * (DFF / 32);
        for (int it = gw; it < 2 * I_G; it += NGW) {
            if (it < I_G) p0_transpose_item(w_gate, DM, DFF, Wgu_t, 5, scr, it, lane, ctl + CW_CMAX);
            else p0_transpose_item(w_up, DM, DFF, Wgu_t, 6, scr, it - I_G, lane, ctl + CW_CMAX);
        }
    }

    for (int g = 0; g < 2; ++g) {
        const float* xin = args.in[g];
        float* outg = args.out + (size_t)g * TOK * DM;
        const int NC = g == 0 ? 128 : 32;
        const int SEQ = g == 0 ? 16384 : 4096;

#ifndef NO_PH_XCVT
        if (g == 0) { PHASE_IDS();
        constexpr long N8 = (long)TOK * DM / 8; long e = gtid;
        for (; e + 3 * NGT < N8; e += 4 * NGT) {
            f32x4 a[4], b[4];
#pragma unroll
            for (int k = 0; k < 4; ++k) { const long ek = e + k * NGT; a[k] = *(const f32x4*)(xin + ek * 8); b[k] = *(const f32x4*)(xin + ek * 8 + 4); }
#pragma unroll
            for (int k = 0; k < 4; ++k) { const long ek = e + k * NGT;
                v4u o; o.x = pk2(a[k][0], a[k][1]); o.y = pk2(a[k][2], a[k][3]); o.z = pk2(b[k][0], b[k][1]); o.w = pk2(b[k][2], b[k][3]);
                *(v4u*)(XB + ek * 8) = o; } }
        for (; e < N8; e += NGT) {
            const f32x4 a = *(const f32x4*)(xin + e * 8), b = *(const f32x4*)(xin + e * 8 + 4);
            v4u o; o.x = pk2(a[0], a[1]); o.y = pk2(a[2], a[3]); o.z = pk2(b[0], b[1]); o.w = pk2(b[2], b[3]);
            *(v4u*)(XB + e * 8) = o; } }
#endif
        if (g == 0) GRID_BAR();

#ifndef NO_PH_P1
        { pg8::Gemm gm{XB, Win_t, TOK, INC, DM}; pg8::StaticOrder S; S.init(TOK, INC, G, bx);
          pg8::EpiProj E{PROJ, INC, (const float*)tabR, (const float*)tabD, SEQ - 1};
          pg8::gemm_phase<pg8::EpiProj, pg8::StaticOrder, true, true>(L, gm, S, E, CUR_TID()); }
#endif
        GRID_BAR();


#ifndef NO_PH_B1
        {
            using namespace att;
            PHASE_IDS();
            const int r32 = lane & 31, hi = lane >> 5, rb = wave & 3, half = wave >> 2;
            for (int u = bx; u < 1024; u += G) {
                const int h = u & 7, gc = u >> 3;
                const float lgf2 = -__expf(dec_f[h]) * 1.4426950408889634f, lgb2 = -__expf(dec_b[h]) * 1.4426950408889634f;
                const bf16* Kp = PROJ + (size_t)gc * 128 * LDP + C_RK + h * 128;
                const bf16* Vp = PROJ + (size_t)gc * 128 * LDP + C_RV + h * 256;
                int t2 = tid; asm volatile("" : "+v"(t2));
#pragma unroll
                for (int i = 0; i < 4; ++i) { const int p = t2 + 512 * i, tok = p >> 4, cb = p & 15;
                    const v4u v = *(const v4u*)(Kp + (size_t)tok * LDP + cb * 8);
                    const float zf = __builtin_amdgcn_exp2f(lgf2 * (float)(127 - tok)), zb = __builtin_amdgcn_exp2f(lgb2 * (float)tok);
                    v4u of, ob;
#pragma unroll
                    for (int j = 0; j < 4; ++j) { const float a = bflo(v[j]), b = bfhi(v[j]); of[j] = pk2(a * zf, b * zf); ob[j] = pk2(a * zb, b * zb); }
                    const int off = (tok >> 6) * 16384 + v_st(tok & 63, cb * 8);
                    *(LAS v4u*)(L + off) = of; *(LAS v4u*)(L + 32768 + off) = ob; }
#pragma unroll
                for (int i = 0; i < 8; ++i) { const int p = t2 + 512 * i, tok = p >> 5, col = (p & 31) * 8;
                    const v4u v = *(const v4u*)(Vp + (size_t)tok * LDP + col);
                    *(LAS v4u*)(L + 65536 + ((tok >> 6) * 2 + (col >> 7)) * 16384 + v_st(tok & 63, col & 127)) = v; }
                __syncthreads();
                const int abase = v_rd_base(lane) + rb * 512, bbase = 65536 + v_rd_base(lane) + half * 16384;
#pragma unroll
                for (int dir = 0; dir < 2; ++dir) {
                    f32x16 acc[4] = {};
#pragma unroll
                    for (int tt = 0; tt < 2; ++tt) {
                        const int ab = abase + dir * 32768 + tt * 16384, bb = bbase + tt * 32768;
#define B1_STEP(KS) do { const s16x4 al = tr_read<v_rd_off(0, KS, 0)>(ab), ah = tr_read<v_rd_off(0, KS, 1)>(ab); \
                        const s16x4 l0 = tr_read<v_rd_off(0, KS, 0)>(bb), h0 = tr_read<v_rd_off(0, KS, 1)>(bb), l1 = tr_read<v_rd_off(1, KS, 0)>(bb), h1 = tr_read<v_rd_off(1, KS, 1)>(bb); \
                        const s16x4 l2 = tr_read<v_rd_off(2, KS, 0)>(bb), h2 = tr_read<v_rd_off(2, KS, 1)>(bb), l3 = tr_read<v_rd_off(3, KS, 0)>(bb), h3 = tr_read<v_rd_off(3, KS, 1)>(bb); \
                        asm volatile("s_waitcnt lgkmcnt(0)" ::: "memory"); SBAR(); const bf16x8 A = PKLH(al, ah); \
                        acc[0] = __builtin_amdgcn_mfma_f32_32x32x16_bf16(A, PKLH(l0, h0), acc[0], 0, 0, 0); acc[1] = __builtin_amdgcn_mfma_f32_32x32x16_bf16(A, PKLH(l1, h1), acc[1], 0, 0, 0); \
                        acc[2] = __builtin_amdgcn_mfma_f32_32x32x16_bf16(A, PKLH(l2, h2), acc[2], 0, 0, 0); acc[3] = __builtin_amdgcn_mfma_f32_32x32x16_bf16(A, PKLH(l3, h3), acc[3], 0, 0, 0); } while (0)
                        B1_STEP(0); B1_STEP(1); B1_STEP(2); B1_STEP(3);
#undef B1_STEP
                    }
                    bf16* dst = KVB + ((size_t)(h * 128 + gc) * 2 + dir) * 32768 + (size_t)(rb * 32) * 256 + half * 128 + r32;
#pragma unroll
                    for (int r = 0; r < 16; ++r)
#pragma unroll
                        for (int d0 = 0; d0 < 4; ++d0) dst[(size_t)crow(r, hi) * 256 + d0 * 32] = (bf16)f2bf(acc[d0][r]);
                }
                __syncthreads();
            }
        }
#endif
        GRID_BAR();

#ifndef NO_PH_B2
        {
            PHASE_IDS();
            const int nseq = TOK / SEQ; const long ntask = (long)8 * nseq * 2 * 8192;
            for (long t = gtid; t < ntask; t += NGT) {
                const int e4 = (int)(t & 8191), dir = (int)(t >> 13) & 1; const int sh = (int)(t >> 14); const int sq = sh % nseq, h = sh / nseq;
                const float dec = __expf(-__expf(dir ? dec_b[h] : dec_f[h]) * 128.0f);
                const size_t off = ((size_t)(h * 128 + sq * NC) * 2 + dir) * 32768 + (size_t)e4 * 4;
                const bf16* src = KVB + off; bf16* dstp = SB + off;
                f32x4 s = {0.f, 0.f, 0.f, 0.f};
                for (int c0 = 0; c0 < NC; c0 += 8) {
                    v2u kv[8];
#pragma unroll
                    for (int j = 0; j < 8; ++j) { const int c = dir ? (NC - 1 - c0 - j) : (c0 + j); kv[j] = *(const v2u*)(src + (size_t)c * 65536); }
#pragma unroll
                    for (int j = 0; j < 8; ++j) { const int c = dir ? (NC - 1 - c0 - j) : (c0 + j);
                        v2u w; w.x = pk2(s[0], s[1]); w.y = pk2(s[2], s[3]); *(v2u*)(dstp + (size_t)c * 65536) = w;
                        s = s * dec + (f32x4){bflo(kv[j][0]), bfhi(kv[j][0]), bflo(kv[j][1]), bfhi(kv[j][1])}; }
                }
            }
        }
#endif
        GRID_BAR();

#ifndef NO_PH_B3
        {
            using namespace att;
            PHASE_IDS();
            const int r32 = lane & 31, hi = lane >> 5, rb = wave & 3, half = wave >> 2;
            char* Lg = (char*)lds;
            for (int u = bx; u < 1024; u += G) {
                const int h = u & 7, gc = u >> 3;
                const float lgf2 = -__expf(dec_f[h]) * 1.4426950408889634f, lgb2 = -__expf(dec_b[h]) * 1.4426950408889634f;
                const size_t row0 = (size_t)gc * 128;
                const bf16* Qp = PROJ + row0 * LDP + C_RQ + h * 128;
                const bf16* Kp = PROJ + row0 * LDP + C_RK + h * 128;
                const bf16* Vp = PROJ + row0 * LDP + C_RV + h * 256;
                const bf16* Sf = SB + ((size_t)(h * 128 + gc) * 2 + 0) * 32768; const bf16* Sb = Sf + 32768;
                int t2 = tid; asm volatile("" : "+v"(t2));
#pragma unroll
                for (int i = 0; i < 4; ++i) { const int p = t2 + 512 * i, tok = p >> 4, cb = p & 15;
                    const v4u v = *(const v4u*)(Kp + (size_t)tok * LDP + cb * 8);
                    *(LAS v4u*)(L + (tok >> 6) * 16384 + KSWZ(tok & 63, cb * 16)) = v; }
#pragma unroll
                for (int i = 0; i < 8; ++i) { const int p = t2 + 512 * i, tok = p >> 5, col = (p & 31) * 8;
                    const v4u v = *(const v4u*)(Vp + (size_t)tok * LDP + col);
                    *(LAS v4u*)(L + 32768 + ((tok >> 6) * 2 + (col >> 7)) * 16384 + v_st(tok & 63, col & 127)) = v; }
                bf16x8 qr[8];
                { const bf16* Qw = Qp + (size_t)(rb * 32 + r32) * LDP + hi * 8;
#pragma unroll
                  for (int d0 = 0; d0 < 8; ++d0) qr[d0] = *(const bf16x8*)(Qw + d0 * 16); }
                __syncthreads();
                f32x16 o[4] = {};
                const int vb = 32768 + v_rd_base(lane) + half * 16384;
                const int irow = rb * 32 + r32;
#pragma unroll
                for (int tt = 0; tt < 2; ++tt) {
                    f32x16 p0, p1; bf16x8 pa0, pa1, pa2, pa3;
                    qkt(p0, p1, (const att::hbf*)(Lg + tt * 16384), qr, r32, hi);
                    int dbase = irow - tt * 64 - 4 * hi; asm volatile("" : "+v"(dbase));
#pragma unroll
                    for (int r = 0; r < 16; ++r) {
                        const int d0 = dbase - ((r & 3) + 8 * (r >> 2)), d1 = d0 - 32;
                        float m0 = __builtin_amdgcn_exp2f((d0 > 0 ? lgf2 : -lgb2) * (float)d0); m0 = d0 == 0 ? 2.0f : m0;
                        float m1 = __builtin_amdgcn_exp2f((d1 > 0 ? lgf2 : -lgb2) * (float)d1); m1 = d1 == 0 ? 2.0f : m1;
                        p0[r] *= m0; p1[r] *= m1; }
                    PK4(p0, 0, pa0); PK4(p0, 8, pa1); PK4(p1, 0, pa2); PK4(p1, 8, pa3);
                    pv_d0(o, vb + tt * 32768, pa0, pa1, pa2, pa3);
                }
#pragma unroll
                for (int dir = 0; dir < 2; ++dir) {
                    __syncthreads();
                    const bf16* Sp = dir ? Sb : Sf;
                    int t3 = tid; asm volatile("" : "+v"(t3));
#pragma unroll
                    for (int i = 0; i < 8; ++i) { const int p = t3 + 512 * i, rw = p >> 5, col = (p & 31) * 8;
                        const v4u w = *(const v4u*)(Sp + (size_t)rw * 256 + col);
                        *(LAS v4u*)(L + 32768 + ((rw >> 6) * 2 + (col >> 7)) * 16384 + v_st(rw & 63, col & 127)) = w; }
                    const float xi = dir ? __builtin_amdgcn_exp2f(lgb2 * (float)(128 - irow)) : __builtin_amdgcn_exp2f(lgf2 * (float)(irow + 1));
                    bf16x8 qs[8];
#pragma unroll
                    for (int d0 = 0; d0 < 8; ++d0) { const v4u w = __builtin_bit_cast(v4u, qr[d0]); v4u x;
#pragma unroll
                        for (int j = 0; j < 4; ++j) x[j] = cvtpk(bflo(w[j]) * xi, bfhi(w[j]) * xi);
                        qs[d0] = __builtin_bit_cast(bf16x8, x); }
                    __syncthreads();
                    pv_d0(o, vb, qs[0], qs[1], qs[2], qs[3]);
                    pv_d0(o, vb + 32768, qs[4], qs[5], qs[6], qs[7]);
                }
                __syncthreads();
                LAS float* ost = (LAS float*)L;
#pragma unroll
                for (int r = 0; r < 16; ++r)
#pragma unroll
                    for (int d0 = 0; d0 < 4; ++d0) ost[(rb * 32 + crow(r, hi)) * 260 + half * 128 + d0 * 32 + r32] = o[d0][r];
                __syncthreads();
                const f32x4 gwv = *(const f32x4*)(gn_w + h * 256 + 4 * lane);
                v2u gts[16];
#pragma unroll
                for (int rr = 0; rr < 16; ++rr) gts[rr] = *(const v2u*)(PROJ + (row0 + wave * 16 + rr) * LDP + C_RG + h * 256 + 4 * lane);
#pragma unroll
                for (int rr = 0; rr < 16; ++rr) {
                    const int row = wave * 16 + rr;
                    const f32x4 v = *(const LAS f32x4*)(ost + row * 260 + 4 * lane);
                    const float mean = wave_sum((v[0] + v[1]) + (v[2] + v[3]), lane) * (1.0f / 256.0f);
                    const f32x4 d = v - mean;
                    const float var = wave_sum((d[0] * d[0] + d[1] * d[1]) + (d[2] * d[2] + d[3] * d[3]), lane) * (1.0f / 256.0f);
                    const float rstd = 1.0f / sqrtf(var + GN_EPS);
                    const v2u gt = gts[rr];
                    const float g0 = bflo(gt[0]), g1 = bfhi(gt[0]), g2 = bflo(gt[1]), g3 = bfhi(gt[1]);
                    v2u w; w.x = pk2(pg8::silu_f(g0) * d[0] * rstd * gwv[0], pg8::silu_f(g1) * d[1] * rstd * gwv[1]);
                    w.y = pk2(pg8::silu_f(g2) * d[2] * rstd * gwv[2], pg8::silu_f(g3) * d[3] * rstd * gwv[3]);
                    *(v2u*)(XB + (row0 + row) * DM + h * 256 + 4 * lane) = w;
                }
                __syncthreads();
            }
        }
#endif
        GRID_BAR();

#ifndef NO_PH_ATT
        {
            const float lam = __uint_as_float(__builtin_amdgcn_readfirstlane(__float_as_uint(PAR[PAR_LAM])));
            for (int i = 0; bx + i * G < 512; ++i) {
                int set, qb;
                if (G == 256) { const int xcd = bx & 7, jb = bx >> 3;
                    if (g == 0) { set = (xcd >> 1) + 4 * i; qb = (xcd & 1) * 32 + jb; } else { set = xcd * 2 + (jb >> 4) + 16 * i; qb = jb & 15; } }
                else { const int u = bx + i * G; if (g == 0) { set = u >> 6; qb = u & 63; } else { set = u >> 4; qb = u & 15; } }
                const int h = set & 7, sq = set >> 3;
                const size_t krow = (size_t)sq * SEQ, qrow = krow + (size_t)qb * 256;
                const att::hbf* Vp = (const att::hbf*)(PROJ + krow * LDP + C_DV + h * 256);
                float* stash = OS + (size_t)bx * 65536;
                { const att::hbf* Qp = (const att::hbf*)(PROJ + qrow * LDP + C_DQ + (2 * h) * 128);
                  const att::hbf* Kp = (const att::hbf*)(PROJ + krow * LDP + C_DK + (2 * h) * 128);
                  att::attn256_unit<0>(Qp, Kp, Vp, SEQ, (char*)lds, CUR_TID(), stash, nullptr, 0.f, nullptr); }
                { const att::hbf* Qp = (const att::hbf*)(PROJ + qrow * LDP + C_DQ + (2 * h + 1) * 128);
                  const att::hbf* Kp = (const att::hbf*)(PROJ + krow * LDP + C_DK + (2 * h + 1) * 128);
                  att::attn256_unit<1>(Qp, Kp, Vp, SEQ, (char*)lds, CUR_TID(), stash, XB + qrow * DM + 2048 + h * 256, lam, subln_w); }
            }
        }
#endif
        GRID_BAR();


#ifndef NO_PH_P3
        { pg8::Gemm gm{XB, Wout_t, TOK, DM, DM}; pg8::StaticOrder S; S.init(TOK, DM, G, bx);
          pg8::EpiBf16 E{MP, DM};
          pg8::gemm_phase<pg8::EpiBf16, pg8::StaticOrder, true, true>(L, gm, S, E, CUR_TID()); }
#endif
        GRID_BAR();

#ifndef NO_PH_LN1
        { PHASE_IDS();
        for (int row = gw; row < TOK; row += NGW) {
            const float* xr = xin + (size_t)row * DM; const bf16* mr = MP + (size_t)row * DM; f32x4 v[16]; float s = 0.f;
#pragma unroll
            for (int j = 0; j < 16; ++j) { const f32x4 xv = *(const f32x4*)(xr + 4 * lane + 256 * j); const v2u m = *(const v2u*)(mr + 4 * lane + 256 * j);
                v[j] = xv * DEEP_ALPHA + (f32x4){bflo(m[0]), bfhi(m[0]), bflo(m[1]), bfhi(m[1])}; s += (v[j][0] + v[j][1]) + (v[j][2] + v[j][3]); }
            const float mean = wave_sum(s, lane) * (1.0f / DM); float q = 0.f;
#pragma unroll
            for (int j = 0; j < 16; ++j) { v[j] = v[j] - mean; q += (v[j][0] * v[j][0] + v[j][1] * v[j][1]) + (v[j][2] * v[j][2] + v[j][3] * v[j][3]); }
            const float rstd = 1.0f / sqrtf(wave_sum(q, lane) * (1.0f / DM) + LN_EPS); float am = 0.f;
#pragma unroll
            for (int j = 0; j < 16; ++j) { const f32x4 gg = *(const f32x4*)(ln1_g + 4 * lane + 256 * j), bb = *(const f32x4*)(ln1_b + 4 * lane + 256 * j);
                const f32x4 y = v[j] * rstd * gg + bb; v[j] = y; am = fmaxf(fmaxf(am, fmaxf(fabsf(y[0]), fabsf(y[1]))), fmaxf(fabsf(y[2]), fabsf(y[3]))); }
            am = fmaxf(wave_max(am, lane), 1e-30f);
            const float qs = 127.f / am;
            if (lane == 0) SAq[row] = am * (1.0f / (127.f * 127.f));
#pragma unroll
            for (int j = 0; j < 16; ++j) { const f32x4 y = v[j];
                v2u w; w.x = pk2(y[0], y[1]); w.y = pk2(y[2], y[3]); *(v2u*)(XB + (size_t)row * DM + 4 * lane + 256 * j) = w;
                XQ[(size_t)row * (DM / 4) + lane + 64 * j] = pk_i8x4(y[0] * qs, y[1] * qs, y[2] * qs, y[3] * qs); }
        } }
#endif
        GRID_BAR();

#ifndef NO_PH_P5
        { pg8::Gemm gm{(const pg8::bf16_t*)XQ, Wgu_t, TOK, NGU, DM / 2}; pg8::StaticOrder S; S.init(TOK, NGU, G, bx);
          pg8::EpiSwiGLUQ E{HB, DFF, SAq, (const float*)(ctl + CW_CMAX)};
          pg8::gemm_phase<pg8::EpiSwiGLUQ, pg8::StaticOrder, true, true, 0, true>(L, gm, S, E, CUR_TID()); }
#endif
        GRID_BAR();

#ifndef NO_PH_P6
        { pg8::Gemm gm{HB, Wd_t, TOK, DM, pg8::HROWB / 2}; pg8::StaticOrder S; S.init(TOK, DM, G, bx);
          pg8::EpiBf16NP E{MP, DM};
          pg8::gemm_phase<pg8::EpiBf16NP, pg8::StaticOrder, true, true, pg8::KT16>(L, gm, S, E, CUR_TID()); }
#endif
        GRID_BAR();

#ifndef NO_PH_LN2
        { PHASE_IDS();
        for (int row = gw; row < TOK; row += NGW) {
            const bf16* xr = XB + (size_t)row * DM; const bf16* mr = MP + (size_t)row * DM; float* yr = outg + (size_t)row * DM; f32x4 v[16]; float s = 0.f;
#pragma unroll
            for (int j = 0; j < 16; ++j) { const v2u xv = *(const v2u*)(xr + 4 * lane + 256 * j); const v2u m = *(const v2u*)(mr + 4 * lane + 256 * j);
                v[j] = (f32x4){bflo(xv[0]), bfhi(xv[0]), bflo(xv[1]), bfhi(xv[1])} * DEEP_ALPHA + (f32x4){bflo(m[0]), bfhi(m[0]), bflo(m[1]), bfhi(m[1])}; s += (v[j][0] + v[j][1]) + (v[j][2] + v[j][3]); }
            const float mean = wave_sum(s, lane) * (1.0f / DM); float q = 0.f;
#pragma unroll
            for (int j = 0; j < 16; ++j) { v[j] = v[j] - mean; q += (v[j][0] * v[j][0] + v[j][1] * v[j][1]) + (v[j][2] * v[j][2] + v[j][3] * v[j][3]); }
            const float rstd = 1.0f / sqrtf(wave_sum(q, lane) * (1.0f / DM) + LN_EPS);
#pragma unroll
            for (int j = 0; j < 16; ++j) { const f32x4 gg = *(const f32x4*)(ln2_g + 4 * lane + 256 * j), bb = *(const f32x4*)(ln2_b + 4 * lane + 256 * j);
                *(f32x4*)(yr + 4 * lane + 256 * j) = v[j] * rstd * gg + bb; }
            if (g == 0) {
                const float* xs = args.in[1] + (size_t)row * DM;
#pragma unroll
                for (int jb = 0; jb < 4; ++jb) { f32x4 t[4];
#pragma unroll
                    for (int j = 0; j < 4; ++j) t[j] = *(const f32x4*)(xs + 4 * lane + 256 * (4 * jb + j));
#pragma unroll
                    for (int j = 0; j < 4; ++j) { v2u w; w.x = pk2(t[j][0], t[j][1]); w.y = pk2(t[j][2], t[j][3]); *(v2u*)(XB + (size_t)row * DM + 4 * lane + 256 * (4 * jb + j)) = w; } }
            }
        } }
#endif
        GRID_BAR();
    }
}

extern "C" void kernel_launch(void* const* d_in, const int* in_sizes, int n_in, void* d_out, int out_size, void* d_ws, size_t ws_size, hipStream_t stream) {
    static int grid = 0;
    if (grid == 0) {
        if (n_in != 19 || in_sizes[0] != TOK * DM || in_sizes[1] != TOK * DM || out_size != 2 * TOK * DM || ws_size < WS_END) {
            fprintf(stderr, "kernel_launch: unexpected shapes: n_in %d in0 %d out %d ws %zu (need >= %zu); nothing launched\n", n_in, n_in > 0 ? in_sizes[0] : -1, out_size, ws_size, (size_t)WS_END); grid = -1; return; }
        int dev = 0, cus = 0, per_cu = 0;
        if (hipGetDevice(&dev) != hipSuccess || hipDeviceGetAttribute(&cus, hipDeviceAttributeMultiprocessorCount, dev) != hipSuccess) { fprintf(stderr, "kernel_launch: device query failed\n"); grid = -1; return; }
        if (hipFuncSetAttribute((const void*)mega_fwd, hipFuncAttributeMaxDynamicSharedMemorySize, LDS_BYTES) != hipSuccess) { fprintf(stderr, "kernel_launch: hipFuncSetAttribute failed\n"); grid = -1; return; }
        if (hipOccupancyMaxActiveBlocksPerMultiprocessor(&per_cu, (const void*)mega_fwd, NWAVES * 64, LDS_BYTES) != hipSuccess || per_cu < 1)
            fprintf(stderr, "kernel_launch: note: occupancy query reports %d workgroups per CU\n", per_cu);
        (void)hipGetLastError();
        grid = cus;
    }
    if (grid < 0) return;
    if (hipMemsetAsync((char*)d_ws + WS_CTL, 0, CTL_ZERO_BYTES, stream) != hipSuccess) { fprintf(stderr, "kernel_launch: memset failed\n"); return; }
    Args a{};
    for (int i = 0; i < 19; ++i) a.in[i] = (const float*)d_in[i];
    a.out = (float*)d_out; a.ws = (unsigned char*)d_ws;
    hipLaunchKernelGGL(mega_fwd, dim3(grid), dim3(NWAVES * 64), LDS_BYTES, stream, a);
    const hipError_t le = hipPeekAtLastError();
    if (le != hipSuccess) fprintf(stderr, "kernel_launch: launch failed: %s\n", hipGetErrorName(le));
}
```

```cpp
#include <hip/hip_runtime.h>
#include <hip/hip_bf16.h>
#include <cstdio>
#include <cstdint>

namespace pg8 {
#define PG8_LAS __attribute__((address_space(3)))
typedef unsigned short bf16_t;
typedef short bf16x8 __attribute__((ext_vector_type(8)));
typedef float f32x4 __attribute__((ext_vector_type(4)));
typedef int i32x4 __attribute__((ext_vector_type(4)));
typedef int i32x8 __attribute__((ext_vector_type(8)));
typedef unsigned u32x4 __attribute__((ext_vector_type(4)));
constexpr int BM = 256, BK = 64, HALF = 128, HTB = HALF * BK * 2, STAGE_BYTES = 8 * HTB, NXCD = 8, WGM = 8;

__host__ __device__ __forceinline__ int lds_byte(int r, int c) { const int st = (r >> 4) * 2 + (c >> 5), rr = r & 15, cc = c & 31, ob = rr * 64 + cc * 2; return st * 1024 + (ob ^ (((ob >> 9) & 1) << 5)); }
__host__ __device__ __forceinline__ void stage_rc(int b, int& R, int& C) { const int st = b / 1024, sb = b % 1024, swz = sb ^ (((sb >> 9) & 1) << 5); R = (st >> 1) * 16 + swz / 64; C = (st & 1) * 32 + (swz % 64) / 2; }
__host__ __device__ __forceinline__ int perm32(int rho) { const int n = rho >> 4, i = rho & 15; return 8 * (i >> 2) + 4 * n + (i & 3); }

struct Unit { int pm, pn; };
struct Gemm { const bf16_t* A; const bf16_t* Bt; int M, N, K; };

struct StaticOrder {
    int nM, nN, nwg, G, c;
    __host__ __device__ void init(int M, int N, int G_, int c_) { nM = M / BM; nN = N / BM; nwg = nM * nN; G = G_; c = c_; }
    __host__ __device__ bool next(int i, Unit& u) const {
        const long L = (long)i * G + c; if (L >= nwg) return false;
        int wgid = (int)L; { const int q = nwg / NXCD, r = nwg % NXCD, xcd = wgid % NXCD, off = wgid / NXCD; wgid = (xcd < r ? xcd * (q + 1) : r * (q + 1) + (xcd - r) * q) + off; }
        const int nig = WGM * nN, gid = wgid / nig, fm = gid * WGM, gsz = (nM - fm) < WGM ? (nM - fm) : WGM;
        u.pm = fm + ((wgid % nig) % gsz); u.pn = (wgid % nig) / gsz; return true;
    }
    __device__ __forceinline__ void a_ready(const Unit&) const {}
    __device__ __forceinline__ void done(const Unit&) const {}
};

__device__ __forceinline__ unsigned cvt_pk_bf16(float lo, float hi) { unsigned r; asm volatile("v_cvt_pk_bf16_f32 %0, %1, %2" : "=v"(r) : "v"(lo), "v"(hi)); return r; }

struct EpiBf16 {
    static constexpr bool PERM = true, AFTER_DRAIN = false;
    bf16_t* O; int ldc;
    __device__ __forceinline__ void operator()(const f32x4 (&acc)[2][2][4][2], const Unit& u, int wr, int wc, int fr, int fq) const {
        const int row0 = u.pm * BM + wr * 64 + fr; const int col0 = u.pn * BM + wc * 32 + 8 * fq;
#pragma unroll
        for (int ai = 0; ai < 2; ++ai)
#pragma unroll
            for (int m = 0; m < 4; ++m) { bf16_t* rowp = O + (size_t)(row0 + ai * HALF + m * 16) * ldc + col0;
#pragma unroll
                for (int bj = 0; bj < 2; ++bj) { const f32x4 v0 = acc[ai][bj][m][0], v1 = acc[ai][bj][m][1];
                    u32x4 w; w.x = cvt_pk_bf16(v0[0], v0[1]); w.y = cvt_pk_bf16(v0[2], v0[3]); w.z = cvt_pk_bf16(v1[0], v1[1]); w.w = cvt_pk_bf16(v1[2], v1[3]);
                    *(u32x4*)(rowp + bj * HALF) = w; } }
    }
};
struct EpiBf16NP {
    static constexpr bool PERM = false, AFTER_DRAIN = false;
    bf16_t* O; int ldc;
    __device__ __forceinline__ void operator()(const f32x4 (&acc)[2][2][4][2], const Unit& u, int wr, int wc, int fr, int fq) const {
        typedef unsigned u32x2 __attribute__((ext_vector_type(2)));
        const int row0 = u.pm * BM + wr * 64 + fr; const int col0 = u.pn * BM + wc * 32 + 4 * fq;
#pragma unroll
        for (int ai = 0; ai < 2; ++ai)
#pragma unroll
            for (int m = 0; m < 4; ++m) { bf16_t* rowp = O + (size_t)(row0 + ai * HALF + m * 16) * ldc + col0;
#pragma unroll
                for (int bj = 0; bj < 2; ++bj)
#pragma unroll
                    for (int n = 0; n < 2; ++n) { const f32x4 v = acc[ai][bj][m][n]; u32x2 w; w.x = cvt_pk_bf16(v[0], v[1]); w.y = cvt_pk_bf16(v[2], v[3]);
                        *(u32x2*)(rowp + bj * HALF + n * 16) = w; } }
    }
};
struct EpiProj {
    static constexpr bool PERM = true, AFTER_DRAIN = false;
    bf16_t* O; int ldc; const float* tabR; const float* tabD; int seqmask;
    __device__ __forceinline__ void operator()(const f32x4 (&acc)[2][2][4][2], const Unit& u, int wr, int wc, int fr, int fq) const {
        typedef float f32x8 __attribute__((ext_vector_type(8)));
        const int row0 = u.pm * BM + wr * 64 + fr; const int col0 = u.pn * BM + wc * 32 + 8 * fq;
        const int pn = u.pn;
        const bool ret = pn < 8, dif = pn >= 24 && pn < 40;
        const float sc = (pn >= 4 && pn < 8) ? 0.088388347648318440f : ((pn >= 24 && pn < 32) ? 0.088388347648318440f * 1.4426950408889634f : 1.0f);
        const bool rot = ret || (dif && wc == 0);
        f32x8 csa[2][4];
#pragma unroll
        for (int ai = 0; ai < 2; ++ai)
#pragma unroll
            for (int m = 0; m < 4; ++m) { const int row = row0 + ai * HALF + m * 16; csa[ai][m] = (f32x8){1.f, 0.f, 1.f, 0.f, 1.f, 0.f, 1.f, 0.f};
                if (rot) { const int pos = row & seqmask; csa[ai][m] = ret ? *(const f32x8*)(tabR + ((size_t)pos * 64 + 4 * (4 * wc + fq)) * 2) : *(const f32x8*)(tabD + ((size_t)pos * 16 + 4 * fq) * 2); } }
#pragma unroll
        for (int ai = 0; ai < 2; ++ai)
#pragma unroll
            for (int m = 0; m < 4; ++m) { const int row = row0 + ai * HALF + m * 16; bf16_t* rowp = O + (size_t)row * ldc + col0;
                const f32x8 cs = csa[ai][m];
#pragma unroll
                for (int bj = 0; bj < 2; ++bj) { const f32x4 v0 = acc[ai][bj][m][0], v1 = acc[ai][bj][m][1]; f32x4 o0, o1;
#pragma unroll
                    for (int k = 0; k < 4; ++k) { o0[k] = (v0[k] * cs[2 * k] - v1[k] * cs[2 * k + 1]) * sc; o1[k] = (v1[k] * cs[2 * k] + v0[k] * cs[2 * k + 1]) * sc; }
                    u32x4 w; w.x = cvt_pk_bf16(o0[0], o0[1]); w.y = cvt_pk_bf16(o0[2], o0[3]); w.z = cvt_pk_bf16(o1[0], o1[1]); w.w = cvt_pk_bf16(o1[2], o1[3]);
                    *(u32x4*)(rowp + bj * HALF) = w; } }
    }
};
__device__ __forceinline__ float silu_f(float x) { return x * __builtin_amdgcn_rcpf(1.0f + __builtin_amdgcn_exp2f(-1.4426950408889634f * x)); }
constexpr int H16 = 1536, H8 = 9472, HROWB = 12544, KT16 = H16 / 64;
static_assert(H16 * 2 + H8 == HROWB && H16 % 128 == 0 && H8 % 256 == 0 && (KT16 % 2) == 0, "mixed hidden row");
template <bool Q> struct EpiSwiGLUT {
    static constexpr bool PERM = true, AFTER_DRAIN = false;
    bf16_t* O; int ldc; const float* SA; const float* CM;
    static __device__ __forceinline__ f32x4 deq(const f32x4 a, const float sa, const f32x4 cm) { if constexpr (!Q) return a; else { const i32x4 i = __builtin_bit_cast(i32x4, a); return (f32x4){(float)i[0] * (sa * cm[0]), (float)i[1] * (sa * cm[1]), (float)i[2] * (sa * cm[2]), (float)i[3] * (sa * cm[3])}; } }
    __device__ __forceinline__ void operator()(const f32x4 (&acc)[2][2][4][2], const Unit& u, int wr, int wc, int fr, int fq) const {
        const int row0 = u.pm * BM + wr * 64 + fr; const int col0 = u.pn * HALF + wc * 32 + 8 * fq;
        f32x4 cg0 = {1.f, 1.f, 1.f, 1.f}, cg1 = cg0, cu0 = cg0, cu1 = cg0;
        if constexpr (Q) { cg0 = *(const f32x4*)(CM + col0); cg1 = *(const f32x4*)(CM + col0 + 4); cu0 = *(const f32x4*)(CM + ldc + col0); cu1 = *(const f32x4*)(CM + ldc + col0 + 4); }
        if (u.pn * HALF >= H16) {
#pragma unroll
            for (int ai = 0; ai < 2; ++ai)
#pragma unroll
                for (int m = 0; m < 4; ++m) { unsigned char* rowp = (unsigned char*)O + (size_t)(row0 + ai * HALF + m * 16) * HROWB + H16 * 2 + (col0 - H16);
                    float sa = 1.f; if constexpr (Q) sa = SA[row0 + ai * HALF + m * 16];
                    const f32x4 g0 = deq(acc[ai][0][m][0], sa, cg0), g1 = deq(acc[ai][0][m][1], sa, cg1), u0 = deq(acc[ai][1][m][0], sa, cu0), u1 = deq(acc[ai][1][m][1], sa, cu1);
                    float v[8];
#pragma unroll
                    for (int j = 0; j < 4; ++j) { v[j] = __builtin_amdgcn_fmed3f(silu_f(g0[j]) * u0[j] * 4.0f, -448.f, 448.f); v[4 + j] = __builtin_amdgcn_fmed3f(silu_f(g1[j]) * u1[j] * 4.0f, -448.f, 448.f); }
                    int w0 = __builtin_amdgcn_cvt_pk_fp8_f32(v[0], v[1], 0, false); w0 = __builtin_amdgcn_cvt_pk_fp8_f32(v[2], v[3], w0, true);
                    int w1 = __builtin_amdgcn_cvt_pk_fp8_f32(v[4], v[5], 0, false); w1 = __builtin_amdgcn_cvt_pk_fp8_f32(v[6], v[7], w1, true);
                    typedef int i32x2 __attribute__((ext_vector_type(2)));
                    *(i32x2*)rowp = (i32x2){w0, w1}; }
            return; }
#pragma unroll
        for (int ai = 0; ai < 2; ++ai)
#pragma unroll
            for (int m = 0; m < 4; ++m) { bf16_t* rowp = (bf16_t*)((unsigned char*)O + (size_t)(row0 + ai * HALF + m * 16) * HROWB) + col0;
                float sa = 1.f; if constexpr (Q) sa = SA[row0 + ai * HALF + m * 16];
                    const f32x4 g0 = deq(acc[ai][0][m][0], sa, cg0), g1 = deq(acc[ai][0][m][1], sa, cg1), u0 = deq(acc[ai][1][m][0], sa, cu0), u1 = deq(acc[ai][1][m][1], sa, cu1);
                f32x4 v0, v1;
#pragma unroll
                for (int j = 0; j < 4; ++j) { v0[j] = silu_f(g0[j]) * u0[j]; v1[j] = silu_f(g1[j]) * u1[j]; }
                u32x4 w; w.x = cvt_pk_bf16(v0[0], v0[1]); w.y = cvt_pk_bf16(v0[2], v0[3]); w.z = cvt_pk_bf16(v1[0], v1[1]); w.w = cvt_pk_bf16(v1[2], v1[3]);
                *(u32x4*)rowp = w; }
    }
};
typedef EpiSwiGLUT<false> EpiSwiGLU; typedef EpiSwiGLUT<true> EpiSwiGLUQ;
constexpr int F8_SC_W = 0x78787878, F8_SC_H = 0x7d7d7d7d;
__device__ __forceinline__ i32x8 cat8(bf16x8 lo, bf16x8 hi) { const i32x4 a = __builtin_bit_cast(i32x4, lo), b = __builtin_bit_cast(i32x4, hi); return __builtin_shufflevector(a, b, 0, 1, 2, 3, 4, 5, 6, 7); }
__device__ __forceinline__ void glds_saddr(unsigned voff, const void* sbase, unsigned lds_dst) { unsigned keep;
    asm volatile("s_mov_b32 %0, m0\n\ts_mov_b32 m0, %3\n\ts_nop 0\n\tglobal_load_lds_dwordx4 %1, %2\n\ts_mov_b32 m0, %0" : "=&s"(keep) : "v"(voff), "s"(sbase), "s"(lds_dst) : "memory"); }
template <class Epi, class Sched, bool ALIGN_EPI = false, bool SP2 = false, int KS8 = 0, bool I8 = false>
__device__ __forceinline__ void gemm_phase(PG8_LAS unsigned char* lds, const Gemm g, const Sched& S, const Epi& E, int tid) {
    asm volatile("" : "+v"(tid));
    const int wid = __builtin_amdgcn_readfirstlane(tid >> 6), lane = tid & 63, wr = wid >> 2, wc = wid & 3, fr = lane & 15, fq = lane >> 4;
    const int K = g.K, nt = K / BK;
    unsigned voffA[2], voffB[2];
#pragma unroll
    for (int i = 0; i < 2; ++i) { int R, C; stage_rc(tid * 16 + i * 8192, R, C); const int Rb = Epi::PERM ? ((R & ~31) + perm32(R & 31)) : R;
        voffA[i] = (unsigned)(R * K + C) * 2u; voffB[i] = (unsigned)(Rb * K + C) * 2u; }
    const size_t kstep = (size_t)(BK * 2);
    const size_t hstep = (size_t)HALF * K * 2;
    const size_t tstep = 2 * hstep;
    const unsigned ldsw = (unsigned)wid * 1024u;
    const int aoff = lds_byte(wr * 64 + fr, fq * 8), boff = lds_byte(wc * 32 + fr, fq * 8);
#define PG8_SA(b, h) (((b) * 2 + (h)) * HTB)
#define PG8_SB(b, h) ((4 + (b) * 2 + (h)) * HTB)
#define PG8_STAGE(bufoff, gbase, voff) do { _Pragma("unroll") for (int _i = 0; _i < 2; ++_i) { \
        if constexpr (KS8 > 0) glds_saddr((voff)[_i], (const void*)(gbase), (unsigned)__builtin_amdgcn_readfirstlane((int)(unsigned)(size_t)(lds + (bufoff) + ldsw + _i * 8192))); \
        else __builtin_amdgcn_global_load_lds((const unsigned*)((const char*)(gbase) + (voff)[_i]), (PG8_LAS unsigned*)(lds + (bufoff) + ldsw + _i * 8192), 16, 0, 0); } } while (0)
#define PG8_LDA(dst, b, h) do { _Pragma("unroll") for (int m = 0; m < 4; ++m) _Pragma("unroll") for (int k = 0; k < 2; ++k) dst[m][k] = *(const PG8_LAS bf16x8*)(lds + PG8_SA(b, h) + aoff + m * 2048 + k * 1024); } while (0)
#define PG8_LDB(dst, b, h) do { _Pragma("unroll") for (int n = 0; n < 2; ++n) _Pragma("unroll") for (int k = 0; k < 2; ++k) dst[n][k] = *(const PG8_LAS bf16x8*)(lds + PG8_SB(b, h) + boff + n * 2048 + k * 1024); } while (0)
#define PG8_MMA(ai, bj, At, Bt) do { __builtin_amdgcn_s_setprio(1); _Pragma("unroll") for (int m = 0; m < 4; ++m) _Pragma("unroll") for (int n = 0; n < 2; ++n) _Pragma("unroll") for (int k = 0; k < 2; ++k) \
        acc[ai][bj][m][n] = __builtin_amdgcn_mfma_f32_16x16x32_bf16(Bt[n][k], At[m][k], acc[ai][bj][m][n], 0, 0, 0); __builtin_amdgcn_s_setprio(0); } while (0)
#define PG8_MMA8(ai, bj, At, Bt) do { __builtin_amdgcn_s_setprio(1); _Pragma("unroll") for (int m = 0; m < 4; ++m) _Pragma("unroll") for (int n = 0; n < 2; ++n) \
        acc[ai][bj][m][n] = __builtin_amdgcn_mfma_scale_f32_16x16x128_f8f6f4(cat8(Bt[n][0], Bt[n][1]), cat8(At[m][0], At[m][1]), acc[ai][bj][m][n], 0, 0, 0, F8_SC_W, 0, F8_SC_H); __builtin_amdgcn_s_setprio(0); } while (0)
#define PG8_MMAI(ai, bj, At, Bt) do { __builtin_amdgcn_s_setprio(1); _Pragma("unroll") for (int m = 0; m < 4; ++m) _Pragma("unroll") for (int n = 0; n < 2; ++n) _Pragma("unroll") for (int k = 0; k < 2; ++k) \
        acc[ai][bj][m][n] = __builtin_bit_cast(f32x4, __builtin_amdgcn_mfma_i32_16x16x64_i8(__builtin_bit_cast(i32x4, Bt[n][k]), __builtin_bit_cast(i32x4, At[m][k]), __builtin_bit_cast(i32x4, acc[ai][bj][m][n]), 0, 0, 0)); __builtin_amdgcn_s_setprio(0); } while (0)
#define PG8_WAIT_V(n) asm volatile("s_waitcnt vmcnt(" #n ")" ::: "memory")
#define PG8_WAIT_L(n) asm volatile("s_waitcnt lgkmcnt(" #n ")" ::: "memory")
#define PG8_BAR __builtin_amdgcn_s_barrier()
#define PG8_SCHED __builtin_amdgcn_sched_barrier(0)
    Unit cur, nxt; int ui = 0;
    if (!S.next(0, cur)) return;
    f32x4 acc[2][2][4][2];
#pragma unroll
    for (int a = 0; a < 2; ++a)
#pragma unroll
        for (int b = 0; b < 2; ++b)
#pragma unroll
            for (int m = 0; m < 4; ++m)
#pragma unroll
                for (int n = 0; n < 2; ++n) acc[a][b][m][n] = (f32x4){0.f, 0.f, 0.f, 0.f};
    bf16x8 At[4][2], B0[2][2], B1[2][2];
    const char* cA = (const char*)g.A + (size_t)cur.pm * tstep; const char* cB = (const char*)g.Bt + (size_t)cur.pn * tstep;
    S.a_ready(cur);
    if constexpr (SP2) {
        PG8_STAGE(PG8_SB(0, 0), cB, voffB); PG8_STAGE(PG8_SB(0, 1), cB + hstep, voffB); PG8_STAGE(PG8_SA(0, 0), cA, voffA); PG8_STAGE(PG8_SA(0, 1), cA + hstep, voffA);
        if (wr == 1) PG8_BAR;
        PG8_WAIT_V(2); PG8_BAR;
        PG8_STAGE(PG8_SB(1, 0), cB + kstep, voffB); PG8_STAGE(PG8_SA(1, 0), cA + kstep, voffA); PG8_STAGE(PG8_SB(1, 1), cB + hstep + kstep, voffB);
        PG8_WAIT_V(6); PG8_BAR;
    } else {
        PG8_STAGE(PG8_SB(0, 0), cB, voffB); PG8_STAGE(PG8_SA(0, 0), cA, voffA); PG8_STAGE(PG8_SB(0, 1), cB + hstep, voffB); PG8_STAGE(PG8_SA(0, 1), cA + hstep, voffA);
        if (wr == 1) PG8_BAR;
        PG8_WAIT_V(4); PG8_BAR;
        PG8_STAGE(PG8_SB(1, 0), cB + kstep, voffB); PG8_STAGE(PG8_SA(1, 0), cA + kstep, voffA); PG8_STAGE(PG8_SB(1, 1), cB + hstep + kstep, voffB);
        PG8_WAIT_V(6); PG8_BAR;
    }
    for (;;) {
        const bool has_next = S.next(ui + 1, nxt);
        const char* nA = has_next ? (const char*)g.A + (size_t)nxt.pm * tstep : cA; const char* nB = has_next ? (const char*)g.Bt + (size_t)nxt.pn * tstep : cB;
#define PG8_ITER_HEAD() \
            const bool last = (t == nt - 2); \
            const char* a1 = cA + (size_t)(t + 1) * kstep; \
            const char* a2 = last ? nA : cA + (size_t)(t + 2) * kstep; const char* b2 = last ? nB : cB + (size_t)(t + 2) * kstep; \
            const char* a3 = a2 + kstep; const char* b3 = b2 + kstep; \
            if (last && has_next) S.a_ready(nxt);
#define PG8_ITER_SP2(MM) \
            PG8_LDB(B0, 0, 0); PG8_LDB(B1, 0, 1); PG8_SCHED; PG8_LDA(At, 0, 0); PG8_STAGE(PG8_SA(1, 1), a1 + hstep, voffA); \
            PG8_WAIT_V(8); PG8_WAIT_L(0); PG8_BAR; MM(0, 0, At, B0); MM(0, 1, At, B1); PG8_BAR; PG8_SCHED; \
            PG8_LDA(At, 0, 1); PG8_STAGE(PG8_SB(0, 0), b2, voffB); PG8_STAGE(PG8_SB(0, 1), b2 + hstep, voffB); PG8_STAGE(PG8_SA(0, 0), a2, voffA); \
            PG8_WAIT_V(8); PG8_WAIT_L(0); PG8_BAR; MM(1, 0, At, B0); MM(1, 1, At, B1); PG8_BAR; PG8_SCHED; \
            PG8_LDB(B0, 1, 0); PG8_LDB(B1, 1, 1); PG8_SCHED; PG8_LDA(At, 1, 0); PG8_STAGE(PG8_SA(0, 1), a2 + hstep, voffA); \
            PG8_WAIT_V(8); PG8_WAIT_L(0); PG8_BAR; MM(0, 0, At, B0); MM(0, 1, At, B1); PG8_BAR; PG8_SCHED; \
            PG8_LDA(At, 1, 1); PG8_STAGE(PG8_SB(1, 0), b3, voffB); PG8_STAGE(PG8_SB(1, 1), b3 + hstep, voffB); PG8_STAGE(PG8_SA(1, 0), a3, voffA); \
            PG8_WAIT_V(8); PG8_WAIT_L(0); PG8_BAR; MM(1, 0, At, B0); MM(1, 1, At, B1); PG8_BAR; PG8_SCHED;
        int t = 0;
        if constexpr (SP2 && I8) {
            for (; t < nt; t += 2) { PG8_ITER_HEAD() PG8_ITER_SP2(PG8_MMAI) }
        } else if constexpr (SP2 && KS8 > 0) {
            for (; t < KS8; t += 2) { PG8_ITER_HEAD() PG8_ITER_SP2(PG8_MMA) }
            for (; t < nt; t += 2) { PG8_ITER_HEAD() PG8_ITER_SP2(PG8_MMA8) }
        } else {
        for (; t < nt; t += 2) {
            PG8_ITER_HEAD()
            if constexpr (SP2) {
            PG8_ITER_SP2(PG8_MMA)
            } else {
            PG8_LDB(B0, 0, 0); PG8_SCHED; PG8_LDA(At, 0, 0); PG8_STAGE(PG8_SA(1, 1), a1 + hstep, voffA);
            PG8_WAIT_L(8); PG8_BAR; PG8_WAIT_L(0); PG8_MMA(0, 0, At, B0); PG8_BAR; PG8_SCHED;
            PG8_LDB(B1, 0, 1); PG8_STAGE(PG8_SB(0, 0), b2, voffB);
            PG8_BAR; PG8_WAIT_L(0); PG8_MMA(0, 1, At, B1); PG8_BAR;
            PG8_LDA(At, 0, 1); PG8_STAGE(PG8_SA(0, 0), a2, voffA);
            PG8_BAR; PG8_WAIT_L(0); PG8_MMA(1, 0, At, B0); PG8_BAR; PG8_SCHED;
            PG8_STAGE(PG8_SB(0, 1), b2 + hstep, voffB);
            PG8_WAIT_V(6); PG8_BAR; PG8_MMA(1, 1, At, B1); PG8_BAR;
            PG8_LDB(B0, 1, 0); PG8_SCHED; PG8_LDA(At, 1, 0); PG8_STAGE(PG8_SA(0, 1), a2 + hstep, voffA);
            PG8_WAIT_L(8); PG8_BAR; PG8_WAIT_L(0); PG8_MMA(0, 0, At, B0); PG8_BAR; PG8_SCHED;
            PG8_LDB(B1, 1, 1); PG8_STAGE(PG8_SB(1, 0), b3, voffB);
            PG8_BAR; PG8_WAIT_L(0); PG8_MMA(0, 1, At, B1); PG8_BAR;
            PG8_LDA(At, 1, 1); PG8_STAGE(PG8_SA(1, 0), a3, voffA);
            PG8_BAR; PG8_WAIT_L(0); PG8_MMA(1, 0, At, B0); PG8_BAR; PG8_SCHED;
            PG8_STAGE(PG8_SB(1, 1), b3 + hstep, voffB);
            PG8_WAIT_V(6); PG8_BAR; PG8_MMA(1, 1, At, B1); PG8_BAR;
            }
        }
        }
        if constexpr (ALIGN_EPI) { if (wr == 0) PG8_BAR; }
        if constexpr (!Epi::AFTER_DRAIN) { int l2; asm volatile("v_mbcnt_lo_u32_b32 %0, -1, 0\n\tv_mbcnt_hi_u32_b32 %0, -1, %0" : "=v"(l2));
            E(acc, cur, wr, wc, l2 & 15, l2 >> 4); S.done(cur); }
        if (!has_next) break;
#pragma unroll
        for (int a = 0; a < 2; ++a)
#pragma unroll
            for (int b = 0; b < 2; ++b)
#pragma unroll
                for (int m = 0; m < 4; ++m)
#pragma unroll
                    for (int n = 0; n < 2; ++n) acc[a][b][m][n] = (f32x4){0.f, 0.f, 0.f, 0.f};
        cur = nxt; cA = nA; cB = nB; ++ui;
        if constexpr (ALIGN_EPI) { if (wr == 1) PG8_BAR; }
    }
    PG8_WAIT_V(0);
    if constexpr (!ALIGN_EPI) { if (wr == 0) PG8_BAR; }
    PG8_BAR;
#undef PG8_SA
#undef PG8_SB
#undef PG8_STAGE
#undef PG8_LDA
#undef PG8_LDB
#undef PG8_MMA
#undef PG8_MMA8
#undef PG8_MMAI
#undef PG8_ITER_HEAD
#undef PG8_ITER_SP2
#undef PG8_WAIT_V
#undef PG8_WAIT_L
#undef PG8_BAR
#undef PG8_SCHED
}
}

constexpr int DM = 4096, TOK = 16384, INC = 12288, DFF = 11008, NGU = 2 * DFF;
constexpr int LDP = INC;
constexpr int C_RQ = 0, C_RK = 1024, C_RV = 2048, C_RG = 4096, C_DQ = 6144, C_DK = 8192, C_DV = 10240;
constexpr float LN_EPS = 1e-5f, GN_EPS = 1e-6f, RMS_EPS = 1e-5f;
constexpr float DEEP_ALPHA = 1.189207115002721f;
constexpr float LAMBDA_INIT = 0.2f;

namespace att {
using hbf = __hip_bfloat16;
constexpr int D = 128, NW = 8, QBLK = 32, KVBLK = 64;
constexpr float SCALE = 0.088388347648318440f;
constexpr float QSCALE = SCALE * 1.4426950408889634f;
constexpr float THR = 8.f;
constexpr int SDEPTH = 2;
constexpr int LDQ = LDP, LDK = LDP, LDO = 2048;
constexpr size_t SHM_V = KVBLK * D * 2, SHM_K = KVBLK * D * 2, SHM_ATTN = 2 * SHM_V + 2 * SHM_K + NW * 64 * 4;
using bf16x8 = __attribute__((ext_vector_type(8))) short;
using s16x4  = __attribute__((ext_vector_type(4))) short;
using f32x16 = __attribute__((ext_vector_type(16))) float;
using u32x4  = __attribute__((ext_vector_type(4))) unsigned;
#define KSWZ(row, colB) ((row) * 256 + ((colB) ^ (((row) & 7) << 4)))
#define SBAR() __builtin_amdgcn_sched_barrier(0)
__device__ __forceinline__ int crow(int r, int hi) { return (r & 3) + 8 * (r >> 2) + 4 * hi; }
__device__ __forceinline__ unsigned cvtpk(float lo, float hi) { unsigned r; asm volatile("v_cvt_pk_bf16_f32 %0, %1, %2" : "=v"(r) : "v"(lo), "v"(hi)); return r; }

#define PK4(P, BASE, OUT) do { unsigned a0 = cvtpk(P[BASE + 0], P[BASE + 1]), a1 = cvtpk(P[BASE + 2], P[BASE + 3]);   \
    unsigned b0 = cvtpk(P[BASE + 4], P[BASE + 5]), b1 = cvtpk(P[BASE + 6], P[BASE + 7]);                              \
    auto r0 = __builtin_amdgcn_permlane32_swap(a0, b0, false, false); auto r1 = __builtin_amdgcn_permlane32_swap(a1, b1, false, false); \
    u32x4 w = {r0[0], r1[0], r0[1], r1[1]}; OUT = *reinterpret_cast<bf16x8*>(&w); } while (0)
__device__ __forceinline__ void qkt(f32x16& p0, f32x16& p1, const hbf* Ks, const bf16x8* qr, int r32, int hi) {
  p0 = f32x16{}; p1 = f32x16{};
#pragma unroll
  for (int d0 = 0; d0 < 8; ++d0) { int cb = (d0 * 16 + hi * 8) * 2;
    bf16x8 b0 = *reinterpret_cast<const bf16x8*>((const char*)Ks + KSWZ(r32, cb));
    bf16x8 b1 = *reinterpret_cast<const bf16x8*>((const char*)Ks + KSWZ(32 + r32, cb));
    p0 = __builtin_amdgcn_mfma_f32_32x32x16_bf16(b0, qr[d0], p0, 0, 0, 0);
    p1 = __builtin_amdgcn_mfma_f32_32x32x16_bf16(b1, qr[d0], p1, 0, 0, 0); }
}
__device__ __forceinline__ int v_st(int k, int c) { const int kk = (k & ~0xC) | ((k & 4) << 1) | ((k & 8) >> 1); return ((kk >> 3) * 4 + (c >> 5)) * 512 + ((kk & 7) * 32 + (c & 31)) * 2; }
__device__ __forceinline__ int v_rd_base(int lane) { return ((lane & 3) << 3) | (((lane >> 2) & 3) << 6) | (((lane >> 4) & 1) << 5) | (((lane >> 5) & 1) << 8); }
constexpr int v_rd_off(int d0, int ks, int half) { return d0 * 512 + ks * 4096 + half * 2048; }
template <int OFF> __device__ __forceinline__ s16x4 tr_read(int vb) {
  s16x4 r; asm volatile("ds_read_b64_tr_b16 %0, %1 offset:%2" : "=&v"(r) : "v"(vb), "i"(OFF) : "memory"); return r;
}
#define PKLH(L, H) (bf16x8){L[0], L[1], L[2], L[3], H[0], H[1], H[2], H[3]}
template <int D0> __device__ __forceinline__ void pv_one(f32x16& od, int vb, bf16x8 pa0, bf16x8 pa1, bf16x8 pa2, bf16x8 pa3) {
  const s16x4 l0 = tr_read<v_rd_off(D0, 0, 0)>(vb), h0 = tr_read<v_rd_off(D0, 0, 1)>(vb), l1 = tr_read<v_rd_off(D0, 1, 0)>(vb), h1 = tr_read<v_rd_off(D0, 1, 1)>(vb);
  const s16x4 l2 = tr_read<v_rd_off(D0, 2, 0)>(vb), h2 = tr_read<v_rd_off(D0, 2, 1)>(vb), l3 = tr_read<v_rd_off(D0, 3, 0)>(vb), h3 = tr_read<v_rd_off(D0, 3, 1)>(vb);
  asm volatile("s_waitcnt lgkmcnt(0)" ::: "memory"); SBAR();
  od = __builtin_amdgcn_mfma_f32_32x32x16_bf16(pa0, PKLH(l0, h0), od, 0, 0, 0);
  od = __builtin_amdgcn_mfma_f32_32x32x16_bf16(pa1, PKLH(l1, h1), od, 0, 0, 0);
  od = __builtin_amdgcn_mfma_f32_32x32x16_bf16(pa2, PKLH(l2, h2), od, 0, 0, 0);
  od = __builtin_amdgcn_mfma_f32_32x32x16_bf16(pa3, PKLH(l3, h3), od, 0, 0, 0);
}
__device__ __forceinline__ void pv_d0(f32x16* o, int vb, bf16x8 pa0, bf16x8 pa1, bf16x8 pa2, bf16x8 pa3) {
  pv_one<0>(o[0], vb, pa0, pa1, pa2, pa3); pv_one<1>(o[1], vb, pa0, pa1, pa2, pa3); pv_one<2>(o[2], vb, pa0, pa1, pa2, pa3); pv_one<3>(o[3], vb, pa0, pa1, pa2, pa3);
}

constexpr float THR2 = 11.5f;
__device__ __forceinline__ float softmax_rel(f32x16& p0, f32x16& p1, bool first, float& m_reg, float& l_reg, bf16x8& pa0, bf16x8& pa1, bf16x8& pa2, bf16x8& pa3) {
  float pmax = p0[0];
#pragma unroll
  for (int r = 1; r < 16; ++r) pmax = fmaxf(pmax, p0[r]);
#pragma unroll
  for (int r = 0; r < 16; ++r) pmax = fmaxf(pmax, p1[r]);
  { auto rr = __builtin_amdgcn_permlane32_swap(__float_as_uint(pmax), __float_as_uint(pmax), false, false);
    pmax = fmaxf(__uint_as_float(rr[0]), __uint_as_float(rr[1])); }
  float alpha = 1.f;
  if (__builtin_expect(first || __any(pmax > THR2), 0)) {
    const float dl = first ? pmax : fmaxf(pmax, 0.f);
    m_reg += dl; alpha = first ? 1.f : __builtin_amdgcn_exp2f(-dl);
#pragma unroll
    for (int r = 0; r < 16; ++r) { p0[r] -= dl; p1[r] -= dl; }
  }
#pragma unroll
  for (int r = 0; r < 16; ++r) p0[r] = __builtin_amdgcn_exp2f(p0[r]);
#pragma unroll
  for (int r = 0; r < 16; ++r) p1[r] = __builtin_amdgcn_exp2f(p1[r]);
  float ps = 0;
#pragma unroll
  for (int r = 0; r < 16; ++r) ps += p0[r];
#pragma unroll
  for (int r = 0; r < 16; ++r) ps += p1[r];
  { auto rr = __builtin_amdgcn_permlane32_swap(__float_as_uint(ps), __float_as_uint(ps), false, false);
    ps = __uint_as_float(rr[0]) + __uint_as_float(rr[1]); }
  l_reg = l_reg * alpha + ps;
  PK4(p0, 0, pa0); PK4(p0, 8, pa1); PK4(p1, 0, pa2); PK4(p1, 8, pa3);
  return alpha;
}
template <int OFF> __device__ __forceinline__ bf16x8 lds_rd128(int addr) { bf16x8 r; asm volatile("ds_read_b128 %0, %1 offset:%2" : "=&v"(r) : "v"(addr), "i"(OFF) : "memory"); return r; }
__device__ __forceinline__ void qkt_pipe(f32x16& p0, f32x16& p1, int kbt, int kc, const bf16x8* qr, const f32x16& z) {
  bf16x8 a0, b0, a1, b1, a2, b2, a3, b3;
#define KRD(A, B, d0) do { const int ad_ = (kc ^ ((d0) << 5)) + kbt; A = lds_rd128<0>(ad_); B = lds_rd128<8192>(ad_); } while (0)
#define KW(N) do { asm volatile("s_waitcnt lgkmcnt(" #N ")" ::: "memory"); SBAR(); } while (0)
  KRD(a0, b0, 0); KRD(a1, b1, 1); KRD(a2, b2, 2); KRD(a3, b3, 3);
  KW(6); p0 = __builtin_amdgcn_mfma_f32_32x32x16_bf16(a0, qr[0], z, 0, 0, 0);  p1 = __builtin_amdgcn_mfma_f32_32x32x16_bf16(b0, qr[0], z, 0, 0, 0);  SBAR(); KRD(a0, b0, 4);
  KW(6); p0 = __builtin_amdgcn_mfma_f32_32x32x16_bf16(a1, qr[1], p0, 0, 0, 0); p1 = __builtin_amdgcn_mfma_f32_32x32x16_bf16(b1, qr[1], p1, 0, 0, 0); SBAR(); KRD(a1, b1, 5);
  KW(6); p0 = __builtin_amdgcn_mfma_f32_32x32x16_bf16(a2, qr[2], p0, 0, 0, 0); p1 = __builtin_amdgcn_mfma_f32_32x32x16_bf16(b2, qr[2], p1, 0, 0, 0); SBAR(); KRD(a2, b2, 6);
  KW(6); p0 = __builtin_amdgcn_mfma_f32_32x32x16_bf16(a3, qr[3], p0, 0, 0, 0); p1 = __builtin_amdgcn_mfma_f32_32x32x16_bf16(b3, qr[3], p1, 0, 0, 0); SBAR(); KRD(a3, b3, 7);
  KW(6); p0 = __builtin_amdgcn_mfma_f32_32x32x16_bf16(a0, qr[4], p0, 0, 0, 0); p1 = __builtin_amdgcn_mfma_f32_32x32x16_bf16(b0, qr[4], p1, 0, 0, 0); SBAR();
  KW(4); p0 = __builtin_amdgcn_mfma_f32_32x32x16_bf16(a1, qr[5], p0, 0, 0, 0); p1 = __builtin_amdgcn_mfma_f32_32x32x16_bf16(b1, qr[5], p1, 0, 0, 0); SBAR();
  KW(2); p0 = __builtin_amdgcn_mfma_f32_32x32x16_bf16(a2, qr[6], p0, 0, 0, 0); p1 = __builtin_amdgcn_mfma_f32_32x32x16_bf16(b2, qr[6], p1, 0, 0, 0); SBAR();
  KW(0); p0 = __builtin_amdgcn_mfma_f32_32x32x16_bf16(a3, qr[7], p0, 0, 0, 0); p1 = __builtin_amdgcn_mfma_f32_32x32x16_bf16(b3, qr[7], p1, 0, 0, 0);
#undef KRD
#undef KW
}
struct VFrag { s16x4 l0, h0, l1, h1, l2, h2, l3, h3; };
template <int D0> __device__ __forceinline__ void vf_read(VFrag& f, int vb) {
  f.l0 = tr_read<v_rd_off(D0, 0, 0)>(vb); f.h0 = tr_read<v_rd_off(D0, 0, 1)>(vb); f.l1 = tr_read<v_rd_off(D0, 1, 0)>(vb); f.h1 = tr_read<v_rd_off(D0, 1, 1)>(vb);
  f.l2 = tr_read<v_rd_off(D0, 2, 0)>(vb); f.h2 = tr_read<v_rd_off(D0, 2, 1)>(vb); f.l3 = tr_read<v_rd_off(D0, 3, 0)>(vb); f.h3 = tr_read<v_rd_off(D0, 3, 1)>(vb);
}
__device__ __forceinline__ void vf_mma(f32x16& od, const VFrag& f, bf16x8 pa0, bf16x8 pa1, bf16x8 pa2, bf16x8 pa3) {
  od = __builtin_amdgcn_mfma_f32_32x32x16_bf16(pa0, PKLH(f.l0, f.h0), od, 0, 0, 0);
  od = __builtin_amdgcn_mfma_f32_32x32x16_bf16(pa1, PKLH(f.l1, f.h1), od, 0, 0, 0);
  od = __builtin_amdgcn_mfma_f32_32x32x16_bf16(pa2, PKLH(f.l2, f.h2), od, 0, 0, 0);
  od = __builtin_amdgcn_mfma_f32_32x32x16_bf16(pa3, PKLH(f.l3, f.h3), od, 0, 0, 0);
}
#define VF_WAIT(N) do { asm volatile("s_waitcnt lgkmcnt(" #N ")" ::: "memory"); SBAR(); } while (0)
__device__ __forceinline__ void pv8(f32x16* o, int vb, bf16x8 pa0, bf16x8 pa1, bf16x8 pa2, bf16x8 pa3) {
  VFrag fa, fb; const int vb2 = vb + 16384;
  vf_read<0>(fa, vb);
  vf_read<1>(fb, vb);  VF_WAIT(8); vf_mma(o[0], fa, pa0, pa1, pa2, pa3); SBAR();
  vf_read<2>(fa, vb);  VF_WAIT(8); vf_mma(o[1], fb, pa0, pa1, pa2, pa3); SBAR();
  vf_read<3>(fb, vb);  VF_WAIT(8); vf_mma(o[2], fa, pa0, pa1, pa2, pa3); SBAR();
  vf_read<0>(fa, vb2); VF_WAIT(8); vf_mma(o[3], fb, pa0, pa1, pa2, pa3); SBAR();
  vf_read<1>(fb, vb2); VF_WAIT(8); vf_mma(o[4], fa, pa0, pa1, pa2, pa3); SBAR();
  vf_read<2>(fa, vb2); VF_WAIT(8); vf_mma(o[5], fb, pa0, pa1, pa2, pa3); SBAR();
  vf_read<3>(fb, vb2); VF_WAIT(8); vf_mma(o[6], fa, pa0, pa1, pa2, pa3); SBAR();
  VF_WAIT(0); vf_mma(o[7], fb, pa0, pa1, pa2, pa3);
}

constexpr int A_LDS_K = 0, A_LDS_V = 49152, A_LDS_WS = 147456;
constexpr long TSTRIDE = 64L * LDP * 2;
__device__ __forceinline__ void glds16(const void* gsrc, unsigned lds_dst) { unsigned keep;
  asm volatile("s_mov_b32 %0, m0\n\ts_mov_b32 m0, %2\n\ts_nop 0\n\tglobal_load_lds_dwordx4 %1, off ; A256DMA\n\ts_mov_b32 m0, %0" : "=&s"(keep) : "v"(gsrc), "s"(lds_dst) : "memory"); }
#define A_WAITBAR(N) asm volatile("s_waitcnt vmcnt(" #N ") lgkmcnt(0) ; A256BAR\n\ts_barrier" ::: "memory")
template <int mode>
__device__ __forceinline__ void attn256_unit(const hbf* __restrict__ Qb, const hbf* __restrict__ Kh, const hbf* __restrict__ Vh, int seq, char* lds, int tid,
                                             float* stash, unsigned short* mixo, float lam, const float* __restrict__ sublnw) {
  asm volatile("" : "+v"(tid));
  const int wid = __builtin_amdgcn_readfirstlane(tid >> 6), lane = tid & 63, r32 = lane & 31, hi = lane >> 5;
  const unsigned lds0 = (unsigned)(uintptr_t)lds;
  float* ws = (float*)(lds + A_LDS_WS) + wid * 64; float* li_l = ws; float* al_l = ws + 32;
  unsigned koff[2], voff[4];
#pragma unroll
  for (int i = 0; i < 2; ++i) { const int row = (wid * 2 + i) * 4 + (lane >> 4), chunk = (lane & 15) ^ (((row & 7) << 1) | ((row >> 3) & 1)); koff[i] = (unsigned)(row * (LDP * 2) + chunk * 16); }
#pragma unroll
  for (int i = 0; i < 4; ++i) { const int q = (wid & 3) * 4 + i, subtile = q * 2 + (lane >> 5), kk = (subtile >> 2) * 8 + ((lane & 31) >> 2);
    const int k = (kk & ~0xC) | ((kk & 4) << 1) | ((kk & 8) >> 1), col = (subtile & 3) * 32 + (lane & 3) * 8;
    voff[i] = (unsigned)(k * (LDP * 2) + ((wid >> 2) * 128 + col) * 2); }
  const char* Kb = (const char*)Kh; const char* Vb = (const char*)Vh;
  const unsigned kdst = lds0 + A_LDS_K + wid * 2048, vdst = lds0 + A_LDS_V + (wid >> 2) * 16384 + (wid & 3) * 4096;
#define RFL(x) ((unsigned)__builtin_amdgcn_readfirstlane((int)(x)))
#define DMA_K(t, sl) do { const char* b_ = Kb + (size_t)(t) * TSTRIDE; const unsigned d_ = RFL(kdst + (sl) * 16384); glds16(b_ + koff[0], d_); glds16(b_ + koff[1], d_ + 1024); } while (0)
#define DMA_V(t, sl) do { const char* b_ = Vb + (size_t)(t) * TSTRIDE; const unsigned d_ = RFL(vdst + (sl) * 32768); glds16(b_ + voff[0], d_); glds16(b_ + voff[1], d_ + 1024); glds16(b_ + voff[2], d_ + 2048); glds16(b_ + voff[3], d_ + 3072); } while (0)
  bf16x8 qr[8];
  { const hbf* Qw = Qb + (long)(wid * QBLK + r32) * LDQ + hi * 8;
#pragma unroll
    for (int d0 = 0; d0 < 8; ++d0) qr[d0] = *reinterpret_cast<const bf16x8*>(Qw + d0 * 16); }
  asm volatile("" : "+v"(qr[0]), "+v"(qr[1]), "+v"(qr[2]), "+v"(qr[3]), "+v"(qr[4]), "+v"(qr[5]), "+v"(qr[6]), "+v"(qr[7]));
  DMA_K(0, 0); DMA_V(0, 0); DMA_K(1, 1); DMA_V(1, 1);
  float m_reg = 0.f, l_reg = 0; f32x16 o[8] = {};
  const int vb0 = (int)(lds0 + A_LDS_V) + v_rd_base(lane);
  const int kb0 = (int)(lds0 + A_LDS_K) + r32 * 256, kc = (hi << 4) ^ ((((r32 & 7) << 1) | ((r32 >> 3) & 1)) << 4);
  const int NT = seq / KVBLK;
#define RESC(a) do { if (__any((a) < 1.f)) { if (hi == 0) al_l[r32] = (a); asm volatile("s_waitcnt lgkmcnt(0)" ::: "memory"); \
    _Pragma("unroll") for (int d = 0; d < 8; ++d) _Pragma("unroll") for (int r = 0; r < 16; ++r) o[d][r] *= al_l[crow(r, hi)]; } } while (0)
  A_WAITBAR(6);
  if (wid >= 4) asm volatile("s_barrier" ::: "memory");
  int s0 = 0, s1 = 1, s2 = 2;
  for (int j = 0; j < NT; ++j) {
    const bool more = j + 2 < NT;
    if (more) DMA_K(j + 2, s2);
    f32x16 p0, p1; bf16x8 pa0, pa1, pa2, pa3;
    __builtin_amdgcn_s_setprio(2);
    { f32x16 negm;
#pragma unroll
      for (int r = 0; r < 16; ++r) negm[r] = -m_reg;
      qkt_pipe(p0, p1, kb0 + s0 * 16384, kc, qr, negm); }
    const float alpha = softmax_rel(p0, p1, j == 0, m_reg, l_reg, pa0, pa1, pa2, pa3);
    RESC(alpha);
    __builtin_amdgcn_s_setprio(0);
    if (more) A_WAITBAR(6); else A_WAITBAR(0);
    if (more) DMA_V(j + 2, s2);
    pv8(o, vb0 + s0 * 32768, pa0, pa1, pa2, pa3);
    if (more) A_WAITBAR(6); else A_WAITBAR(0);
    { const int t_ = s0; s0 = s1; s1 = s2; s2 = t_; }
  }
  if (wid < 4) asm volatile("s_barrier" ::: "memory");
  if (hi == 0) li_l[r32] = l_reg; asm volatile("s_waitcnt lgkmcnt(0)" ::: "memory");
  float rli[16];
#pragma unroll
  for (int r = 0; r < 16; ++r) rli[r] = __builtin_amdgcn_rcpf(li_l[crow(r, hi)]);
  typedef float f32x4_t __attribute__((ext_vector_type(4)));
  f32x4_t* st4 = (f32x4_t*)stash + (size_t)wid * 2048 + lane;
  if constexpr (mode == 0) {
#pragma unroll
    for (int d0 = 0; d0 < 8; ++d0)
#pragma unroll
      for (int q = 0; q < 4; ++q) st4[(d0 * 4 + q) * 64] = (f32x4_t){o[d0][4 * q] * rli[4 * q], o[d0][4 * q + 1] * rli[4 * q + 1], o[d0][4 * q + 2] * rli[4 * q + 2], o[d0][4 * q + 3] * rli[4 * q + 3]};
  } else {
    typedef __attribute__((address_space(3))) float lds_f32;
    lds_f32* rs = (lds_f32*)(lds0 + A_LDS_WS + wid * 256 + 128);
    if (hi == 0) rs[r32] = 0.f;
    float ss[16];
#pragma unroll
    for (int r = 0; r < 16; ++r) ss[r] = 0.f;
#pragma unroll
    for (int d0 = 0; d0 < 8; ++d0) {
      f32x4_t a0, a1, a2, a3;
      { typedef unsigned long long u64; const u64* p0 = (const u64*)&st4[(d0 * 4 + 0) * 64]; const u64* p1 = (const u64*)&st4[(d0 * 4 + 1) * 64]; const u64* p2 = (const u64*)&st4[(d0 * 4 + 2) * 64]; const u64* p3 = (const u64*)&st4[(d0 * 4 + 3) * 64];
        const u64 x0 = __hip_atomic_load(p0, __ATOMIC_RELAXED, __HIP_MEMORY_SCOPE_AGENT), x1 = __hip_atomic_load(p0 + 1, __ATOMIC_RELAXED, __HIP_MEMORY_SCOPE_AGENT);
        const u64 y0 = __hip_atomic_load(p1, __ATOMIC_RELAXED, __HIP_MEMORY_SCOPE_AGENT), y1 = __hip_atomic_load(p1 + 1, __ATOMIC_RELAXED, __HIP_MEMORY_SCOPE_AGENT);
        const u64 z0 = __hip_atomic_load(p2, __ATOMIC_RELAXED, __HIP_MEMORY_SCOPE_AGENT), z1 = __hip_atomic_load(p2 + 1, __ATOMIC_RELAXED, __HIP_MEMORY_SCOPE_AGENT);
        const u64 w0 = __hip_atomic_load(p3, __ATOMIC_RELAXED, __HIP_MEMORY_SCOPE_AGENT), w1 = __hip_atomic_load(p3 + 1, __ATOMIC_RELAXED, __HIP_MEMORY_SCOPE_AGENT);
        a0 = (f32x4_t){__uint_as_float((unsigned)x0), __uint_as_float((unsigned)(x0 >> 32)), __uint_as_float((unsigned)x1), __uint_as_float((unsigned)(x1 >> 32))};
        a1 = (f32x4_t){__uint_as_float((unsigned)y0), __uint_as_float((unsigned)(y0 >> 32)), __uint_as_float((unsigned)y1), __uint_as_float((unsigned)(y1 >> 32))};
        a2 = (f32x4_t){__uint_as_float((unsigned)z0), __uint_as_float((unsigned)(z0 >> 32)), __uint_as_float((unsigned)z1), __uint_as_float((unsigned)(z1 >> 32))};
        a3 = (f32x4_t){__uint_as_float((unsigned)w0), __uint_as_float((unsigned)(w0 >> 32)), __uint_as_float((unsigned)w1), __uint_as_float((unsigned)(w1 >> 32))}; }
#pragma unroll
      for (int k = 0; k < 4; ++k) {
        float d;
        d = a0[k] - lam * (o[d0][k] * rli[k]);           o[d0][k] = d;      ss[k] += d * d;
        d = a1[k] - lam * (o[d0][4 + k] * rli[4 + k]);   o[d0][4 + k] = d;  ss[4 + k] += d * d;
        d = a2[k] - lam * (o[d0][8 + k] * rli[8 + k]);   o[d0][8 + k] = d;  ss[8 + k] += d * d;
        d = a3[k] - lam * (o[d0][12 + k] * rli[12 + k]); o[d0][12 + k] = d; ss[12 + k] += d * d; }
      asm volatile("" : "+v"(o[d0]) :: "memory");
    }
    asm volatile("s_waitcnt lgkmcnt(0)" ::: "memory");
#pragma unroll
    for (int r = 0; r < 16; ++r) __hip_atomic_fetch_add(rs + crow(r, hi), ss[r], __ATOMIC_RELAXED, __HIP_MEMORY_SCOPE_WORKGROUP);
    asm volatile("s_waitcnt lgkmcnt(0)" ::: "memory");
#pragma unroll
    for (int r = 0; r < 16; ++r) ss[r] = (1.0f - LAMBDA_INIT) / sqrtf(rs[crow(r, hi)] * (1.0f / 256.0f) + RMS_EPS);
    unsigned short* stg = (unsigned short*)(lds + wid * 16384);
#pragma unroll
    for (int d0 = 0; d0 < 8; ++d0) { const float sw = sublnw[d0 * 32 + r32];
#pragma unroll
      for (int r = 0; r < 16; ++r) stg[crow(r, hi) * 256 + d0 * 32 + r32] = (unsigned short)(cvtpk(o[d0][r] * ss[r] * sw, 0.f) & 0xffffu); }
    asm volatile("s_waitcnt lgkmcnt(0)" ::: "memory");
    unsigned short* Mw = mixo + (size_t)(wid * QBLK) * DM;
#pragma unroll
    for (int i = 0; i < 16; ++i) { const int p = i * 64 + lane, row = p >> 5, ch = p & 31;
      const u32x4 v = *(const u32x4*)(stg + row * 256 + ch * 8); *(u32x4*)(Mw + (size_t)row * DM + ch * 8) = v; }
    asm volatile("s_waitcnt lgkmcnt(0)\n\ts_barrier" ::: "memory");
  }
#undef RESC
#undef DMA_K
#undef DMA_V
#undef RFL
}
}

constexpr int NWAVES = 8;
constexpr size_t MiB = 1u << 20;
constexpr size_t WS_CTL = 0, CTL_ZERO_BYTES = 1 * MiB;
constexpr size_t WS_PAR = 1 * MiB;
constexpr int PAR_DECF = 0, PAR_DECB = 8, PAR_LQ1 = 16, PAR_LK1 = 144, PAR_LQ2 = 272, PAR_LK2 = 400, PAR_SUBLN = 528, PAR_GNW = 784, PAR_LN1G = 2832, PAR_LN1B = 6928, PAR_LN2G = 11024, PAR_LN2B = 15120, PAR_LAM = 19216, PAR_END = 19232;
constexpr size_t WS_TABR = 2 * MiB;
constexpr size_t WS_TABD = 10 * MiB;
constexpr size_t WS_WIN = 12 * MiB;
constexpr size_t WS_WOUT = 108 * MiB;
constexpr size_t WS_WGU = 140 * MiB;
constexpr size_t WS_XQ = 228 * MiB;
constexpr size_t WS_SA = 292 * MiB;
constexpr size_t WS_WD = 312 * MiB;
constexpr size_t WS_XB = 398 * MiB;
constexpr size_t WS_PROJ = 526 * MiB;
constexpr size_t WS_OS = 910 * MiB;
constexpr size_t WS_END = 1166 * MiB;
static_assert(WS_WIN + (size_t)INC * DM * 2 <= WS_WOUT && WS_WOUT + (size_t)DM * DM * 2 <= WS_WGU && WS_WGU + (size_t)NGU * DM * 2 <= WS_WD && WS_WD + (size_t)DM * DFF * 2 <= WS_XB, "ws map");
static_assert(WS_XB + (size_t)TOK * DM * 2 <= WS_PROJ && WS_PROJ + (size_t)TOK * INC * 2 <= WS_OS && WS_OS + (size_t)2 * TOK * 2048 * 4 <= WS_END, "ws map");
constexpr int CW_BAR = 4096;
constexpr int CW_CMAX = 32768;
static_assert(WS_WGU + (size_t)NGU * DM <= WS_XQ && WS_XQ + (size_t)TOK * DM <= WS_SA && WS_SA + (size_t)TOK * 4 <= WS_WD && (CW_CMAX + 2 * DFF) * 4 <= (int)CTL_ZERO_BYTES, "ws map (int8 operands)");
constexpr int RING_BYTES = 131072;
constexpr int LDSCTL_OFF = 147456 + 2048, MISC_OFF = LDSCTL_OFF + 320;
constexpr int LDS_BYTES = 163840;

#define LAS __attribute__((address_space(3)))
typedef unsigned short bf16;
typedef unsigned v4u __attribute__((ext_vector_type(4)));
typedef unsigned v2u __attribute__((ext_vector_type(2)));
typedef float f32x4 __attribute__((ext_vector_type(4)));
typedef int i32x4 __attribute__((ext_vector_type(4)));
typedef int i32x8 __attribute__((ext_vector_type(8)));
typedef float f32x2 __attribute__((ext_vector_type(2)));
#define LDS_WAIT() asm volatile("s_waitcnt lgkmcnt(0)" ::: "memory")
__device__ __forceinline__ unsigned f2bf(float f) { unsigned u = __builtin_bit_cast(unsigned, f); return (u + 0x7fffu + ((u >> 16) & 1u)) >> 16; }
__device__ __forceinline__ unsigned pk2(float lo, float hi) { return f2bf(lo) | (f2bf(hi) << 16); }
__device__ __forceinline__ float bflo(unsigned w) { return __uint_as_float(w << 16); }
__device__ __forceinline__ float bfhi(unsigned w) { return __uint_as_float(w & 0xffff0000u); }

#define XB_TMO      128
#define XB_XCNT(j)  (256  + 64 * (j))
#define XB_XSUB(j)  (1280 + 64 * (j))
#define XB_XGEN(j)  (2304 + 64 * (j))
#define XB_TOP      3328
#define XB_TOPGEN   3392
#define XCD_BAR_WORDS 3456
#define XB_SPIN_CAP (1u << 18)
__device__ __forceinline__ unsigned xb_ld(unsigned* p)              { asm volatile("" : "+v"(p)); return __hip_atomic_load(p, __ATOMIC_RELAXED, __HIP_MEMORY_SCOPE_AGENT); }
__device__ __forceinline__ unsigned xb_add(unsigned* p, unsigned v) { asm volatile("" : "+v"(p)); return __hip_atomic_fetch_add(p, v, __ATOMIC_RELAXED, __HIP_MEMORY_SCOPE_AGENT); }
__device__ __forceinline__ unsigned xb_xcc_id() { return (unsigned)__builtin_amdgcn_s_getreg((3 << 11) | 20) & 0xFu; }
#define XB_SPIN(cond, bar) do { unsigned _sp = 0; while (cond) { __builtin_amdgcn_s_sleep(1); \
    if ((++_sp & 255u) == 0u) { if (xb_ld(&(bar)[XB_TMO])) break; if (_sp > XB_SPIN_CAP) { (void)xb_add(&(bar)[XB_TMO], 1u); break; } } } } while (0)
struct XcdBarrier { unsigned* bar; unsigned x; volatile LAS unsigned* st; };
__device__ __forceinline__ XcdBarrier xcd_barrier_post(unsigned* bar, volatile LAS unsigned* st, int tid) {
    XcdBarrier b; b.bar = bar; b.x = xb_xcc_id(); b.st = st;
    if (tid == 0) (void)xb_add(&bar[XB_XCNT(b.x)], 1u);
    return b;
}
__device__ __forceinline__ void xcd_barrier_complete(unsigned* bar, unsigned x, unsigned& nloc, unsigned& nx) {
    const unsigned G = gridDim.x * gridDim.y * gridDim.z;
    unsigned sum, cnt, mine, sp = 0u;
    for (;;) {
        sum = 0u; cnt = 0u; mine = 0u;
#pragma unroll
        for (unsigned j = 0; j < 16; ++j) { const unsigned c = xb_ld(&bar[XB_XCNT(j)]); sum += c; cnt += (c > 0u) ? 1u : 0u; mine = (j == x) ? c : mine; }
        if (sum == G) break;
        __builtin_amdgcn_s_sleep(1);
        if ((++sp & 255u) == 0u) { if (xb_ld(&bar[XB_TMO])) break; if (sp > XB_SPIN_CAP) { (void)xb_add(&bar[XB_TMO], 1u); break; } }
    }
    nloc = mine > 0u ? mine : 1u; nx = cnt > 0u ? cnt : 1u;
}
__device__ __forceinline__ void xcd_barrier(const XcdBarrier& b, int tid) {
    asm volatile("s_waitcnt vmcnt(0)" ::: "memory");
    __syncthreads();
    if (tid == 0) {
        unsigned* bar = b.bar;
        __builtin_amdgcn_s_waitcnt(0);
        unsigned nloc = b.st[0], nx = b.st[1];
        if (nloc == 0u) { xcd_barrier_complete(bar, b.x, nloc, nx); b.st[0] = nloc; b.st[1] = nx; }
        const unsigned old = xb_add(&bar[XB_XSUB(b.x)], 1u);
        const unsigned gen = old / nloc;
        if (old + 1u == (gen + 1u) * nloc) {
            __builtin_amdgcn_fence(__ATOMIC_RELEASE, "agent");
            asm volatile("s_waitcnt vmcnt(0)" ::: "memory");
            const unsigned og = xb_add(&bar[XB_TOP], 1u);
            const unsigned tg = og / nx;
            if (og + 1u == (tg + 1u) * nx) xb_add(&bar[XB_TOPGEN], 1u);
            else XB_SPIN(xb_ld(&bar[XB_TOPGEN]) == tg, bar);
            __builtin_amdgcn_fence(__ATOMIC_ACQUIRE, "agent");
            xb_add(&bar[XB_XGEN(b.x)], 1u);
            asm volatile("s_waitcnt vmcnt(0)" ::: "memory");
        } else {
            XB_SPIN(xb_ld(&bar[XB_XGEN(b.x)]) == gen, bar);
            __builtin_amdgcn_fence(__ATOMIC_ACQUIRE, "agent");
            asm volatile("s_waitcnt vmcnt(0)" ::: "memory");
        }
    }
    __syncthreads();
}

__device__ __forceinline__ float wave_sum(float v, int lane) {
#pragma unroll
    for (int o = 1; o < 64; o <<= 1) v += __int_as_float(__builtin_amdgcn_ds_bpermute((lane ^ o) << 2, __float_as_int(v)));
    return v;
}

__device__ __forceinline__ float wave_max(float v, int lane) {
#pragma unroll
    for (int o = 1; o < 64; o <<= 1) v = fmaxf(v, __int_as_float(__builtin_amdgcn_ds_bpermute((lane ^ o) << 2, __float_as_int(v))));
    return v;
}
__device__ __forceinline__ unsigned pk_i8x4(float a, float b, float c, float d) {
    const unsigned u0 = __float_as_uint(a + 12582912.f), u1 = __float_as_uint(b + 12582912.f), u2 = __float_as_uint(c + 12582912.f), u3 = __float_as_uint(d + 12582912.f);
    return (u0 & 255u) | ((u1 & 255u) << 8) | ((u2 & 255u) << 16) | (u3 << 24);
}

__host__ __device__ __forceinline__ int rowmap_in(int n) {
    if (n < 2048) { const int d = n & 127; const int p = (d < 64) ? (8 * (d >> 2) + (d & 3)) : (8 * ((d - 64) >> 2) + 4 + (d & 3)); return (n & ~127) + p; }
    if (n >= 6144 && n < 10240) { const int d = n & 127; if (d < 32) { const int p = (d < 16) ? (8 * (d >> 2) + (d & 3)) : (8 * ((d - 16) >> 2) + 4 + (d & 3)); return (n & ~127) + p; } }
    return n;
}
__device__ __forceinline__ void p0_transpose_item(const float* W, int K, int N, bf16* WT, int mode, LAS float* scr, int item, int lane, const unsigned* cmax = nullptr) {
    const int nblk = N / 32, kb = item / nblk, nb = item % nblk, k0 = 64 * kb, n0 = 32 * nb;
    const int rbase = (mode == 0 || mode == 3 || mode == 4) ? n0 : (n0 + (n0 >> 7) * 128 + ((mode == 2 || mode == 6) ? 128 : 0));
    float tv[32];
#pragma unroll
    for (int i = 0; i < 32; ++i) { const int kk = 2 * i + (lane >> 5); tv[i] = W[(size_t)(k0 + kk) * N + n0 + (lane & 31)]; }
#pragma unroll
    for (int i = 0; i < 32; ++i) { const int kk = 2 * i + (lane >> 5); scr[kk * 33 + (lane & 31)] = tv[i]; }
    LDS_WAIT(); asm volatile("" ::: "memory");
    const int c = lane & 7;
#pragma unroll
    for (int j = 0; j < 4; ++j) { const int n = (lane >> 3) + 8 * j; const LAS float* s = scr + (8 * c) * 33 + n;
        v4u o; o.x = pk2(s[0 * 33], s[1 * 33]); o.y = pk2(s[2 * 33], s[3 * 33]); o.z = pk2(s[4 * 33], s[5 * 33]); o.w = pk2(s[6 * 33], s[7 * 33]);
        if (mode == 4) {
            unsigned char* rowb = (unsigned char*)WT + (size_t)(n0 + n) * pg8::HROWB;
            if (k0 < pg8::H16) *(v4u*)(rowb + (size_t)(k0 + 8 * c) * 2) = o;
            else { float q[8];
#pragma unroll
                   for (int i = 0; i < 8; ++i) q[i] = __builtin_amdgcn_fmed3f(s[i * 33] * 128.f, -448.f, 448.f);
                   int w0 = __builtin_amdgcn_cvt_pk_fp8_f32(q[0], q[1], 0, false); w0 = __builtin_amdgcn_cvt_pk_fp8_f32(q[2], q[3], w0, true);
                   int w1 = __builtin_amdgcn_cvt_pk_fp8_f32(q[4], q[5], 0, false); w1 = __builtin_amdgcn_cvt_pk_fp8_f32(q[6], q[7], w1, true);
                   v2u o8; o8.x = (unsigned)w0; o8.y = (unsigned)w1; *(v2u*)(rowb + pg8::H16 * 2 + (k0 - pg8::H16) + 8 * c) = o8; }
            continue; }
        if (mode >= 5) { const float sc = 127.f / fmaxf(__uint_as_float(cmax[(mode == 6 ? N : 0) + n0 + n]), 1e-30f);
            v2u o8; o8.x = pk_i8x4(s[0 * 33] * sc, s[1 * 33] * sc, s[2 * 33] * sc, s[3 * 33] * sc); o8.y = pk_i8x4(s[4 * 33] * sc, s[5 * 33] * sc, s[6 * 33] * sc, s[7 * 33] * sc);
            *(v2u*)((unsigned char*)WT + (size_t)(rbase + n) * K + k0 + 8 * c) = o8; continue; }
        const int drow = (mode == 3) ? rowmap_in(n0 + n) : (rbase + n);
        *(v4u*)(WT + (size_t)drow * K + k0 + 8 * c) = o; }
    LDS_WAIT(); asm volatile("" ::: "memory");
}
__device__ __forceinline__ void sincos_d(double a, float& s, float& c) {
    const double q = rint(a * 0.63661977236758134308);
    double r = fma(-q, 1.57079632679489655800e+00, a); r = fma(-q, 6.12323399573676603587e-17, r);
    const double r2 = r * r;
    const double sp = r * (1.0 + r2 * (-1.0 / 6 + r2 * (1.0 / 120 + r2 * (-1.0 / 5040 + r2 * (1.0 / 362880 + r2 * (-1.0 / 39916800 + r2 * (1.0 / 6227020800.0)))))));
    const double cp = 1.0 + r2 * (-0.5 + r2 * (1.0 / 24 + r2 * (-1.0 / 720 + r2 * (1.0 / 40320 + r2 * (-1.0 / 3628800 + r2 * (1.0 / 479001600.0 + r2 * (-1.0 / 87178291200.0)))))));
    const int qi = (int)q & 3;
    double ss = (qi & 1) ? cp : sp, cc = (qi & 1) ? sp : cp;
    if (qi == 1) cc = -cc;
    if (qi == 2) { ss = -ss; cc = -cc; }
    if (qi == 3) ss = -ss;
    s = (float)ss; c = (float)cc;
}

__device__ __forceinline__ int lane_id_v() { int r; asm volatile("v_mbcnt_lo_u32_b32 %0, -1, 0\n\tv_mbcnt_hi_u32_b32 %0, -1, %0" : "=v"(r)); return r; }
struct Args { const float* in[19]; float* out; unsigned char* ws; };

__global__ void __launch_bounds__(NWAVES * 64, 2) mega_fwd(Args args) {
    extern __shared__ __attribute__((aligned(16))) unsigned char lds[];
    LAS unsigned char* L = (LAS unsigned char*)lds;
    volatile LAS unsigned* MISC = (volatile LAS unsigned*)(L + MISC_OFF);
    const int G = gridDim.x, bx = blockIdx.x;
    const int NGW = G * NWAVES; const long NGT = (long)G * 512;
    const int wave_s = __builtin_amdgcn_readfirstlane((int)threadIdx.x >> 6);
#define LANE_ID() lane_id_v()
#define CUR_TID() (wave_s * 64 + LANE_ID())
#define PHASE_IDS() int wv_ = wave_s; asm volatile("" : "+s"(wv_)); const int wave = wv_; int tid = wave * 64 + LANE_ID(); asm volatile("" : "+v"(tid)); const int lane = tid & 63; (void)lane; \
    const int gw = bx * NWAVES + wave; const long gtid = (long)bx * 512 + tid; (void)gw; (void)gtid
#define GRID_BAR() xcd_barrier(bar, CUR_TID())
    unsigned char* ws = args.ws;
    unsigned* ctl = (unsigned*)(ws + WS_CTL);
    for (int u = threadIdx.x; u < (LDS_BYTES - LDSCTL_OFF) / 4; u += NWAVES * 64) ((LAS unsigned*)(L + LDSCTL_OFF))[u] = 0u;
    __syncthreads();
    XcdBarrier bar = xcd_barrier_post(ctl + CW_BAR, MISC + 8, (int)threadIdx.x);

    const float* PAR = (const float*)(ws + WS_PAR);
    const float* dec_f = PAR + PAR_DECF; const float* dec_b = PAR + PAR_DECB; const float* gn_w = PAR + PAR_GNW;
    const float* lq1 = PAR + PAR_LQ1; const float* lk1 = PAR + PAR_LK1; const float* lq2 = PAR + PAR_LQ2; const float* lk2 = PAR + PAR_LK2;
    const float* subln_w = PAR + PAR_SUBLN; const float* ln1_g = PAR + PAR_LN1G; const float* ln1_b = PAR + PAR_LN1B; const float* ln2_g = PAR + PAR_LN2G; const float* ln2_b = PAR + PAR_LN2B;
    bf16* Win_t = (bf16*)(ws + WS_WIN); bf16* Wout_t = (bf16*)(ws + WS_WOUT); bf16* Wgu_t = (bf16*)(ws + WS_WGU); bf16* Wd_t = (bf16*)(ws + WS_WD);
    bf16* XB = (bf16*)(ws + WS_XB); bf16* PROJ = (bf16*)(ws + WS_PROJ); bf16* HB = (bf16*)(ws + WS_PROJ); float* OS = (float*)(ws + WS_OS); bf16* KVB = (bf16*)(ws + WS_OS); bf16* SB = (bf16*)(ws + WS_OS + 128 * MiB); bf16* MP = (bf16*)(ws + WS_OS);
    f32x2* tabR = (f32x2*)(ws + WS_TABR); f32x2* tabD = (f32x2*)(ws + WS_TABD);
    unsigned* XQ = (unsigned*)(ws + WS_XQ); float* SAq = (float*)(ws + WS_SA);

    {
        PHASE_IDS();
        const float* w_in = args.in[2]; const float* w_out = args.in[11]; const float* w_gate = args.in[14]; const float* w_up = args.in[15]; const float* w_down = args.in[16];
        { float* P = (float*)(ws + WS_PAR);
          if (bx == 0) {
            for (int i = tid; i < 8; i += 512) { P[PAR_DECF + i] = args.in[3][i]; P[PAR_DECB + i] = args.in[4][i]; }
            for (int i = tid; i < 128; i += 512) { P[PAR_LQ1 + i] = args.in[6][i]; P[PAR_LK1 + i] = args.in[7][i]; P[PAR_LQ2 + i] = args.in[8][i]; P[PAR_LK2 + i] = args.in[9][i]; }
            for (int i = tid; i < 256; i += 512) P[PAR_SUBLN + i] = args.in[10][i];
            for (int i = tid; i < 2048; i += 512) P[PAR_GNW + i] = args.in[5][i];
            for (int i = tid; i < 4096; i += 512) { P[PAR_LN1G + i] = args.in[12][i]; P[PAR_LN1B + i] = args.in[13][i]; P[PAR_LN2G + i] = args.in[17][i]; P[PAR_LN2B + i] = args.in[18][i]; }
            if (wave == 0) {
              float a = args.in[6][lane] * args.in[7][lane] + args.in[6][lane + 64] * args.in[7][lane + 64], b = args.in[8][lane] * args.in[9][lane] + args.in[8][lane + 64] * args.in[9][lane + 64];
              a = wave_sum(a, lane); b = wave_sum(b, lane); if (lane == 0) P[PAR_LAM] = __expf(a) - __expf(b) + LAMBDA_INIT; }
          } }
        LAS float* scr = (LAS float*)(L + wave * 16384);
        constexpr int I_IN = (DM / 64) * (INC / 32), I_OUT = (DM / 64) * (DM / 32), I_G = (DM / 64) * (DFF / 32), I_D = (DFF / 64) * (DM / 32);
        constexpr int NITEMS = I_IN + I_OUT + I_D;
        for (int it = gw; it < NITEMS; it += NGW) {
            int r = it;
            if (r < I_IN) { p0_transpose_item(w_in, DM, INC, Win_t, 3, scr, r, lane); continue; } r -= I_IN;
            if (r < I_OUT) { p0_transpose_item(w_out, DM, DM, Wout_t, 0, scr, r, lane); continue; } r -= I_OUT;
            p0_transpose_item(w_down, DFF, DM, Wd_t, 4, scr, r, lane);
        }
        for (int it = gw; it < 2 * 16 * 43; it += NGW) { const int mat = it / 688, r = it % 688, kb = r / 43, cb = r % 43;
            const float* Wp = (mat ? w_up : w_gate) + (size_t)(kb * 256) * DFF + cb * 256 + 4 * lane;
            f32x4 mx = {0.f, 0.f, 0.f, 0.f};
            for (int i0 = 0; i0 < 256; i0 += 16) { f32x4 t[16];
#pragma unroll
                for (int i = 0; i < 16; ++i) t[i] = *(const f32x4*)(Wp + (size_t)(i0 + i) * DFF);
#pragma unroll
                for (int i = 0; i < 16; ++i) { mx[0] = fmaxf(mx[0], fabsf(t[i][0])); mx[1] = fmaxf(mx[1], fabsf(t[i][1])); mx[2] = fmaxf(mx[2], fabsf(t[i][2])); mx[3] = fmaxf(mx[3], fabsf(t[i][3])); } }
            unsigned* cmp = ctl + CW_CMAX + mat * DFF + cb * 256 + 4 * lane;
#pragma unroll
            for (int c = 0; c < 4; ++c) __hip_atomic_fetch_max(cmp + c, __float_as_uint(mx[c]), __ATOMIC_RELAXED, __HIP_MEMORY_SCOPE_AGENT); }
        for (long e = gtid; e < 16384L * 64; e += NGT) { const int pos = (int)(e >> 6), i = (int)(e & 63);
            const double inv = exp(-(double)i * (9.210340371976184 / 64.0));
            float s, c; sincos_d((double)pos * inv, s, c); tabR[e] = (f32x2){c, s}; }
        for (long e = gtid; e < 16384L * 16; e += NGT) { const int pos = (int)(e >> 4), i = (int)(e & 15);
            const double inv = exp(-(double)i * (13.122363377404328 / 16.0));
            float s, c; sincos_d((double)pos * inv, s, c); tabD[e] = (f32x2){c, s}; }
    }
    GRID_BAR();
    {
        PHASE_IDS();
        const float* w_gate = args.in[14]; const float* w_up = args.in[15];
        LAS float* scr = (LAS float*)(L + wave * 16384);
        constexpr int I_G = (DM / 64) * (DFF / 32);
        for (int it = gw; it < 2 * I_G; it += NGW) {
            if (it < I_G) p0_transpose_item(w_gate, DM, DFF, Wgu_t, 5, scr, it, lane, ctl + CW_CMAX);
            else p0_transpose_item(w_up, DM, DFF, Wgu_t, 6, scr, it - I_G, lane, ctl + CW_CMAX);
        }
    }

    for (int g = 0; g < 2; ++g) {
        const float* xin = args.in[g];
        float* outg = args.out + (size_t)g * TOK * DM;
        const int NC = g == 0 ? 128 : 32;
        const int SEQ = g == 0 ? 16384 : 4096;

#ifndef NO_PH_XCVT
        if (g == 0) { PHASE_IDS();
        constexpr long N8 = (long)TOK * DM / 8; long e = gtid;
        for (; e + 3 * NGT < N8; e += 4 * NGT) {
            f32x4 a[4], b[4];
#pragma unroll
            for (int k = 0; k < 4; ++k) { const long ek = e + k * NGT; a[k] = *(const f32x4*)(xin + ek * 8); b[k] = *(const f32x4*)(xin + ek * 8 + 4); }
#pragma unroll
            for (int k = 0; k < 4; ++k) { const long ek = e + k * NGT;
                v4u o; o.x = pk2(a[k][0], a[k][1]); o.y = pk2(a[k][2], a[k][3]); o.z = pk2(b[k][0], b[k][1]); o.w = pk2(b[k][2], b[k][3]);
                *(v4u*)(XB + ek * 8) = o; } }
        for (; e < N8; e += NGT) {
            const f32x4 a = *(const f32x4*)(xin + e * 8), b = *(const f32x4*)(xin + e * 8 + 4);
            v4u o; o.x = pk2(a[0], a[1]); o.y = pk2(a[2], a[3]); o.z = pk2(b[0], b[1]); o.w = pk2(b[2], b[3]);
            *(v4u*)(XB + e * 8) = o; } }
#endif
        if (g == 0) GRID_BAR();

#ifndef NO_PH_P1
        { pg8::Gemm gm{XB, Win_t, TOK, INC, DM}; pg8::StaticOrder S; S.init(TOK, INC, G, bx);
          pg8::EpiProj E{PROJ, INC, (const float*)tabR, (const float*)tabD, SEQ - 1};
          pg8::gemm_phase<pg8::EpiProj, pg8::StaticOrder, true, true>(L, gm, S, E, CUR_TID()); }
#endif
        GRID_BAR();


#ifndef NO_PH_B1
        {
            using namespace att;
            PHASE_IDS();
            const int r32 = lane & 31, hi = lane >> 5, rb = wave & 3, half = wave >> 2;
            for (int u = bx; u < 1024; u += G) {
                const int h = u & 7, gc = u >> 3;
                const float lgf2 = -__expf(dec_f[h]) * 1.4426950408889634f, lgb2 = -__expf(dec_b[h]) * 1.4426950408889634f;
                const bf16* Kp = PROJ + (size_t)gc * 128 * LDP + C_RK + h * 128;
                const bf16* Vp = PROJ + (size_t)gc * 128 * LDP + C_RV + h * 256;
                int t2 = tid; asm volatile("" : "+v"(t2));
#pragma unroll
                for (int i = 0; i < 4; ++i) { const int p = t2 + 512 * i, tok = p >> 4, cb = p & 15;
                    const v4u v = *(const v4u*)(Kp + (size_t)tok * LDP + cb * 8);
                    const float zf = __builtin_amdgcn_exp2f(lgf2 * (float)(127 - tok)), zb = __builtin_amdgcn_exp2f(lgb2 * (float)tok);
                    v4u of, ob;
#pragma unroll
                    for (int j = 0; j < 4; ++j) { const float a = bflo(v[j]), b = bfhi(v[j]); of[j] = pk2(a * zf, b * zf); ob[j] = pk2(a * zb, b * zb); }
                    const int off = (tok >> 6) * 16384 + v_st(tok & 63, cb * 8);
                    *(LAS v4u*)(L + off) = of; *(LAS v4u*)(L + 32768 + off) = ob; }
#pragma unroll
                for (int i = 0; i < 8; ++i) { const int p = t2 + 512 * i, tok = p >> 5, col = (p & 31) * 8;
                    const v4u v = *(const v4u*)(Vp + (size_t)tok * LDP + col);
                    *(LAS v4u*)(L + 65536 + ((tok >> 6) * 2 + (col >> 7)) * 16384 + v_st(tok & 63, col & 127)) = v; }
                __syncthreads();
                const int abase = v_rd_base(lane) + rb * 512, bbase = 65536 + v_rd_base(lane) + half * 16384;
#pragma unroll
                for (int dir = 0; dir < 2; ++dir) {
                    f32x16 acc[4] = {};
#pragma unroll
                    for (int tt = 0; tt < 2; ++tt) {
                        const int ab = abase + dir * 32768 + tt * 16384, bb = bbase + tt * 32768;
#define B1_STEP(KS) do { const s16x4 al = tr_read<v_rd_off(0, KS, 0)>(ab), ah = tr_read<v_rd_off(0, KS, 1)>(ab); \
                        const s16x4 l0 = tr_read<v_rd_off(0, KS, 0)>(bb), h0 = tr_read<v_rd_off(0, KS, 1)>(bb), l1 = tr_read<v_rd_off(1, KS, 0)>(bb), h1 = tr_read<v_rd_off(1, KS, 1)>(bb); \
                        const s16x4 l2 = tr_read<v_rd_off(2, KS, 0)>(bb), h2 = tr_read<v_rd_off(2, KS, 1)>(bb), l3 = tr_read<v_rd_off(3, KS, 0)>(bb), h3 = tr_read<v_rd_off(3, KS, 1)>(bb); \
                        asm volatile("s_waitcnt lgkmcnt(0)" ::: "memory"); SBAR(); const bf16x8 A = PKLH(al, ah); \
                        acc[0] = __builtin_amdgcn_mfma_f32_32x32x16_bf16(A, PKLH(l0, h0), acc[0], 0, 0, 0); acc[1] = __builtin_amdgcn_mfma_f32_32x32x16_bf16(A, PKLH(l1, h1), acc[1], 0, 0, 0); \
                        acc[2] = __builtin_amdgcn_mfma_f32_32x32x16_bf16(A, PKLH(l2, h2), acc[2], 0, 0, 0); acc[3] = __builtin_amdgcn_mfma_f32_32x32x16_bf16(A, PKLH(l3, h3), acc[3], 0, 0, 0); } while (0)
                        B1_STEP(0); B1_STEP(1); B1_STEP(2); B1_STEP(3);
#undef B1_STEP
                    }
                    bf16* dst = KVB + ((size_t)(h * 128 + gc) * 2 + dir) * 32768 + (size_t)(rb * 32) * 256 + half * 128 + r32;
#pragma unroll
                    for (int r = 0; r < 16; ++r)
#pragma unroll
                        for (int d0 = 0; d0 < 4; ++d0) dst[(size_t)crow(r, hi) * 256 + d0 * 32] = (bf16)f2bf(acc[d0][r]);
                }
                __syncthreads();
            }
        }
#endif
        GRID_BAR();

#ifndef NO_PH_B2
        {
            PHASE_IDS();
            const int nseq = TOK / SEQ; const long ntask = (long)8 * nseq * 2 * 8192;
            for (long t = gtid; t < ntask; t += NGT) {
                const int e4 = (int)(t & 8191), dir = (int)(t >> 13) & 1; const int sh = (int)(t >> 14); const int sq = sh % nseq, h = sh / nseq;
                const float dec = __expf(-__expf(dir ? dec_b[h] : dec_f[h]) * 128.0f);
                const size_t off = ((size_t)(h * 128 + sq * NC) * 2 + dir) * 32768 + (size_t)e4 * 4;
                const bf16* src = KVB + off; bf16* dstp = SB + off;
                f32x4 s = {0.f, 0.f, 0.f, 0.f};
                for (int c0 = 0; c0 < NC; c0 += 8) {
                    v2u kv[8];
#pragma unroll
                    for (int j = 0; j < 8; ++j) { const int c = dir ? (NC - 1 - c0 - j) : (c0 + j); kv[j] = *(const v2u*)(src + (size_t)c * 65536); }
#pragma unroll
                    for (int j = 0; j < 8; ++j) { const int c = dir ? (NC - 1 - c0 - j) : (c0 + j);
                        v2u w; w.x = pk2(s[0], s[1]); w.y = pk2(s[2], s[3]); *(v2u*)(dstp + (size_t)c * 65536) = w;
                        s = s * dec + (f32x4){bflo(kv[j][0]), bfhi(kv[j][0]), bflo(kv[j][1]), bfhi(kv[j][1])}; }
                }
            }
        }
#endif
        GRID_BAR();

#ifndef NO_PH_B3
        {
            using namespace att;
            PHASE_IDS();
            const int r32 = lane & 31, hi = lane >> 5, rb = wave & 3, half = wave >> 2;
            char* Lg = (char*)lds;
            for (int u = bx; u < 1024; u += G) {
                const int h = u & 7, gc = u >> 3;
                const float lgf2 = -__expf(dec_f[h]) * 1.4426950408889634f, lgb2 = -__expf(dec_b[h]) * 1.4426950408889634f;
                const size_t row0 = (size_t)gc * 128;
                const bf16* Qp = PROJ + row0 * LDP + C_RQ + h * 128;
                const bf16* Kp = PROJ + row0 * LDP + C_RK + h * 128;
                const bf16* Vp = PROJ + row0 * LDP + C_RV + h * 256;
                const bf16* Sf = SB + ((size_t)(h * 128 + gc) * 2 + 0) * 32768; const bf16* Sb = Sf + 32768;
                int t2 = tid; asm volatile("" : "+v"(t2));
#pragma unroll
                for (int i = 0; i < 4; ++i) { const int p = t2 + 512 * i, tok = p >> 4, cb = p & 15;
                    const v4u v = *(const v4u*)(Kp + (size_t)tok * LDP + cb * 8);
                    *(LAS v4u*)(L + (tok >> 6) * 16384 + KSWZ(tok & 63, cb * 16)) = v; }
#pragma unroll
                for (int i = 0; i < 8; ++i) { const int p = t2 + 512 * i, tok = p >> 5, col = (p & 31) * 8;
                    const v4u v = *(const v4u*)(Vp + (size_t)tok * LDP + col);
                    *(LAS v4u*)(L + 32768 + ((tok >> 6) * 2 + (col >> 7)) * 16384 + v_st(tok & 63, col & 127)) = v; }
                bf16x8 qr[8];
                { const bf16* Qw = Qp + (size_t)(rb * 32 + r32) * LDP + hi * 8;
#pragma unroll
                  for (int d0 = 0; d0 < 8; ++d0) qr[d0] = *(const bf16x8*)(Qw + d0 * 16); }
                v4u wst[8];
                { int t3 = tid; asm volatile("" : "+v"(t3));
#pragma unroll
                  for (int i = 0; i < 8; ++i) { const int p = t3 + 512 * i, rw = p >> 5, col = (p & 31) * 8; wst[i] = *(const v4u*)(Sf + (size_t)rw * 256 + col); } }
                __syncthreads();
                f32x16 o[4] = {};
                const int vb = 32768 + v_rd_base(lane) + half * 16384;
                const int irow = rb * 32 + r32;
#pragma unroll
                for (int tt = 0; tt < 2; ++tt) {
                    f32x16 p0, p1; bf16x8 pa0, pa1, pa2, pa3;
                    qkt(p0, p1, (const att::hbf*)(Lg + tt * 16384), qr, r32, hi);
                    int dbase = irow - tt * 64 - 4 * hi; asm volatile("" : "+v"(dbase));
#pragma unroll
                    for (int r = 0; r < 16; ++r) {
                        const int d0 = dbase - ((r & 3) + 8 * (r >> 2)), d1 = d0 - 32;
                        float m0 = __builtin_amdgcn_exp2f((d0 > 0 ? lgf2 : -lgb2) * (float)d0); m0 = d0 == 0 ? 2.0f : m0;
                        float m1 = __builtin_amdgcn_exp2f((d1 > 0 ? lgf2 : -lgb2) * (float)d1); m1 = d1 == 0 ? 2.0f : m1;
                        p0[r] *= m0; p1[r] *= m1; }
                    PK4(p0, 0, pa0); PK4(p0, 8, pa1); PK4(p1, 0, pa2); PK4(p1, 8, pa3);
                    pv_d0(o, vb + tt * 32768, pa0, pa1, pa2, pa3);
                }
                v2u gts[16];
#pragma unroll
                for (int dir = 0; dir < 2; ++dir) {
                    __syncthreads();
                    int t3 = tid; asm volatile("" : "+v"(t3));
#pragma unroll
                    for (int i = 0; i < 8; ++i) { const int p = t3 + 512 * i, rw = p >> 5, col = (p & 31) * 8;
                        *(LAS v4u*)(L + 32768 + ((rw >> 6) * 2 + (col >> 7)) * 16384 + v_st(rw & 63, col & 127)) = wst[i]; }
                    if (dir == 0) {
#pragma unroll
                        for (int i = 0; i < 8; ++i) { const int p = t3 + 512 * i, rw = p >> 5, col = (p & 31) * 8; wst[i] = *(const v4u*)(Sb + (size_t)rw * 256 + col); }
                    } else {
#pragma unroll
                        for (int rr = 0; rr < 16; ++rr) gts[rr] = *(const v2u*)(PROJ + (row0 + wave * 16 + rr) * LDP + C_RG + h * 256 + 4 * lane);
                    }
                    const float xi = dir ? __builtin_amdgcn_exp2f(lgb2 * (float)(128 - irow)) : __builtin_amdgcn_exp2f(lgf2 * (float)(irow + 1));
                    bf16x8 qs[8];
#pragma unroll
                    for (int d0 = 0; d0 < 8; ++d0) { const v4u w = __builtin_bit_cast(v4u, qr[d0]); v4u x;
#pragma unroll
                        for (int j = 0; j < 4; ++j) x[j] = cvtpk(bflo(w[j]) * xi, bfhi(w[j]) * xi);
                        qs[d0] = __builtin_bit_cast(bf16x8, x); }
                    __syncthreads();
                    pv_d0(o, vb, qs[0], qs[1], qs[2], qs[3]);
                    pv_d0(o, vb + 32768, qs[4], qs[5], qs[6], qs[7]);
                }
                __syncthreads();
                LAS float* ost = (LAS float*)L;
#pragma unroll
                for (int r = 0; r < 16; ++r)
#pragma unroll
                    for (int d0 = 0; d0 < 4; ++d0) ost[(rb * 32 + crow(r, hi)) * 260 + half * 128 + d0 * 32 + r32] = o[d0][r];
                __syncthreads();
                const f32x4 gwv = *(const f32x4*)(gn_w + h * 256 + 4 * lane);
#pragma unroll
                for (int rr = 0; rr < 16; ++rr) {
                    const int row = wave * 16 + rr;
                    const f32x4 v = *(const LAS f32x4*)(ost + row * 260 + 4 * lane);
                    const float mean = wave_sum((v[0] + v[1]) + (v[2] + v[3]), lane) * (1.0f / 256.0f);
                    const f32x4 d = v - mean;
                    const float var = wave_sum((d[0] * d[0] + d[1] * d[1]) + (d[2] * d[2] + d[3] * d[3]), lane) * (1.0f / 256.0f);
                    const float rstd = 1.0f / sqrtf(var + GN_EPS);
                    const v2u gt = gts[rr];
                    const float g0 = bflo(gt[0]), g1 = bfhi(gt[0]), g2 = bflo(gt[1]), g3 = bfhi(gt[1]);
                    v2u w; w.x = pk2(pg8::silu_f(g0) * d[0] * rstd * gwv[0], pg8::silu_f(g1) * d[1] * rstd * gwv[1]);
                    w.y = pk2(pg8::silu_f(g2) * d[2] * rstd * gwv[2], pg8::silu_f(g3) * d[3] * rstd * gwv[3]);
                    *(v2u*)(XB + (row0 + row) * DM + h * 256 + 4 * lane) = w;
                }
                __syncthreads();
            }
        }
#endif
        GRID_BAR();

#ifndef NO_PH_ATT
        {
            const float lam = __uint_as_float(__builtin_amdgcn_readfirstlane(__float_as_uint(PAR[PAR_LAM])));
            for (int i = 0; bx + i * G < 512; ++i) {
                int set, qb;
                if (G == 256) { const int xcd = bx & 7, jb = bx >> 3;
                    if (g == 0) { set = (xcd >> 1) + 4 * i; qb = (xcd & 1) * 32 + jb; } else { set = xcd * 2 + (jb >> 4) + 16 * i; qb = jb & 15; } }
                else { const int u = bx + i * G; if (g == 0) { set = u >> 6; qb = u & 63; } else { set = u >> 4; qb = u & 15; } }
                const int h = set & 7, sq = set >> 3;
                const size_t krow = (size_t)sq * SEQ, qrow = krow + (size_t)qb * 256;
                const att::hbf* Vp = (const att::hbf*)(PROJ + krow * LDP + C_DV + h * 256);
                float* stash = OS + (size_t)bx * 65536;
                { const att::hbf* Qp = (const att::hbf*)(PROJ + qrow * LDP + C_DQ + (2 * h) * 128);
                  const att::hbf* Kp = (const att::hbf*)(PROJ + krow * LDP + C_DK + (2 * h) * 128);
                  att::attn256_unit<0>(Qp, Kp, Vp, SEQ, (char*)lds, CUR_TID(), stash, nullptr, 0.f, nullptr); }
                { const att::hbf* Qp = (const att::hbf*)(PROJ + qrow * LDP + C_DQ + (2 * h + 1) * 128);
                  const att::hbf* Kp = (const att::hbf*)(PROJ + krow * LDP + C_DK + (2 * h + 1) * 128);
                  att::attn256_unit<1>(Qp, Kp, Vp, SEQ, (char*)lds, CUR_TID(), stash, XB + qrow * DM + 2048 + h * 256, lam, subln_w); }
            }
        }
#endif
        GRID_BAR();


#ifndef NO_PH_P3
        { pg8::Gemm gm{XB, Wout_t, TOK, DM, DM}; pg8::StaticOrder S; S.init(TOK, DM, G, bx);
          pg8::EpiBf16 E{MP, DM};
          pg8::gemm_phase<pg8::EpiBf16, pg8::StaticOrder, true, true>(L, gm, S, E, CUR_TID()); }
#endif
        GRID_BAR();

#ifndef NO_PH_LN1
        { PHASE_IDS();
        for (int row = gw; row < TOK; row += NGW) {
            const float* xr = xin + (size_t)row * DM; const bf16* mr = MP + (size_t)row * DM; f32x4 v[16]; float s = 0.f;
#pragma unroll
            for (int j = 0; j < 16; ++j) { const f32x4 xv = *(const f32x4*)(xr + 4 * lane + 256 * j); const v2u m = *(const v2u*)(mr + 4 * lane + 256 * j);
                v[j] = xv * DEEP_ALPHA + (f32x4){bflo(m[0]), bfhi(m[0]), bflo(m[1]), bfhi(m[1])}; s += (v[j][0] + v[j][1]) + (v[j][2] + v[j][3]); }
            const float mean = wave_sum(s, lane) * (1.0f / DM); float q = 0.f;
#pragma unroll
            for (int j = 0; j < 16; ++j) { v[j] = v[j] - mean; q += (v[j][0] * v[j][0] + v[j][1] * v[j][1]) + (v[j][2] * v[j][2] + v[j][3] * v[j][3]); }
            const float rstd = 1.0f / sqrtf(wave_sum(q, lane) * (1.0f / DM) + LN_EPS); float am = 0.f;
#pragma unroll
            for (int j = 0; j < 16; ++j) { const f32x4 gg = *(const f32x4*)(ln1_g + 4 * lane + 256 * j), bb = *(const f32x4*)(ln1_b + 4 * lane + 256 * j);
                const f32x4 y = v[j] * rstd * gg + bb; v[j] = y; am = fmaxf(fmaxf(am, fmaxf(fabsf(y[0]), fabsf(y[1]))), fmaxf(fabsf(y[2]), fabsf(y[3]))); }
            am = fmaxf(wave_max(am, lane), 1e-30f);
            const float qs = 127.f / am;
            if (lane == 0) SAq[row] = am * (1.0f / (127.f * 127.f));
#pragma unroll
            for (int j = 0; j < 16; ++j) { const f32x4 y = v[j];
                v2u w; w.x = pk2(y[0], y[1]); w.y = pk2(y[2], y[3]); *(v2u*)(XB + (size_t)row * DM + 4 * lane + 256 * j) = w;
                XQ[(size_t)row * (DM / 4) + lane + 64 * j] = pk_i8x4(y[0] * qs, y[1] * qs, y[2] * qs, y[3] * qs); }
        } }
#endif
        GRID_BAR();

#ifndef NO_PH_P5
        { pg8::Gemm gm{(const pg8::bf16_t*)XQ, Wgu_t, TOK, NGU, DM / 2}; pg8::StaticOrder S; S.init(TOK, NGU, G, bx);
          pg8::EpiSwiGLUQ E{HB, DFF, SAq, (const float*)(ctl + CW_CMAX)};
          pg8::gemm_phase<pg8::EpiSwiGLUQ, pg8::StaticOrder, true, true, 0, true>(L, gm, S, E, CUR_TID()); }
#endif
        GRID_BAR();

#ifndef NO_PH_P6
        { pg8::Gemm gm{HB, Wd_t, TOK, DM, pg8::HROWB / 2}; pg8::StaticOrder S; S.init(TOK, DM, G, bx);
          pg8::EpiBf16NP E{MP, DM};
          pg8::gemm_phase<pg8::EpiBf16NP, pg8::StaticOrder, true, true, pg8::KT16>(L, gm, S, E, CUR_TID()); }
#endif
        GRID_BAR();

#ifndef NO_PH_LN2
        { PHASE_IDS();
        for (int row = gw; row < TOK; row += NGW) {
            const bf16* xr = XB + (size_t)row * DM; const bf16* mr = MP + (size_t)row * DM; float* yr = outg + (size_t)row * DM; f32x4 v[16]; float s = 0.f;
#pragma unroll
            for (int j = 0; j < 16; ++j) { const v2u xv = *(const v2u*)(xr + 4 * lane + 256 * j); const v2u m = *(const v2u*)(mr + 4 * lane + 256 * j);
                v[j] = (f32x4){bflo(xv[0]), bfhi(xv[0]), bflo(xv[1]), bfhi(xv[1])} * DEEP_ALPHA + (f32x4){bflo(m[0]), bfhi(m[0]), bflo(m[1]), bfhi(m[1])}; s += (v[j][0] + v[j][1]) + (v[j][2] + v[j][3]); }
            const float mean = wave_sum(s, lane) * (1.0f / DM); float q = 0.f;
#pragma unroll
            for (int j = 0; j < 16; ++j) { v[j] = v[j] - mean; q += (v[j][0] * v[j][0] + v[j][1] * v[j][1]) + (v[j][2] * v[j][2] + v[j][3] * v[j][3]); }
            const float rstd = 1.0f / sqrtf(wave_sum(q, lane) * (1.0f / DM) + LN_EPS);
#pragma unroll
            for (int j = 0; j < 16; ++j) { const f32x4 gg = *(const f32x4*)(ln2_g + 4 * lane + 256 * j), bb = *(const f32x4*)(ln2_b + 4 * lane + 256 * j);
                *(f32x4*)(yr + 4 * lane + 256 * j) = v[j] * rstd * gg + bb; }
            if (g == 0) {
                const float* xs = args.in[1] + (size_t)row * DM;
#pragma unroll
                for (int jb = 0; jb < 4; ++jb) { f32x4 t[4];
#pragma unroll
                    for (int j = 0; j < 4; ++j) t[j] = *(const f32x4*)(xs + 4 * lane + 256 * (4 * jb + j));
#pragma unroll
                    for (int j = 0; j < 4; ++j) { v2u w; w.x = pk2(t[j][0], t[j][1]); w.y = pk2(t[j][2], t[j][3]); *(v2u*)(XB + (size_t)row * DM + 4 * lane + 256 * (4 * jb + j)) = w; } }
            }
        } }
#endif
        GRID_BAR();
    }
}

extern "C" void kernel_launch(void* const* d_in, const int* in_sizes, int n_in, void* d_out, int out_size, void* d_ws, size_t ws_size, hipStream_t stream) {
    static int grid = 0;
    if (grid == 0) {
        if (n_in != 19 || in_sizes[0] != TOK * DM || in_sizes[1] != TOK * DM || out_size != 2 * TOK * DM || ws_size < WS_END) {
            fprintf(stderr, "kernel_launch: unexpected shapes: n_in %d in0 %d out %d ws %zu (need >= %zu); nothing launched\n", n_in, n_in > 0 ? in_sizes[0] : -1, out_size, ws_size, (size_t)WS_END); grid = -1; return; }
        int dev = 0, cus = 0, per_cu = 0;
        if (hipGetDevice(&dev) != hipSuccess || hipDeviceGetAttribute(&cus, hipDeviceAttributeMultiprocessorCount, dev) != hipSuccess) { fprintf(stderr, "kernel_launch: device query failed\n"); grid = -1; return; }
        if (hipFuncSetAttribute((const void*)mega_fwd, hipFuncAttributeMaxDynamicSharedMemorySize, LDS_BYTES) != hipSuccess) { fprintf(stderr, "kernel_launch: hipFuncSetAttribute failed\n"); grid = -1; return; }
        if (hipOccupancyMaxActiveBlocksPerMultiprocessor(&per_cu, (const void*)mega_fwd, NWAVES * 64, LDS_BYTES) != hipSuccess || per_cu < 1)
            fprintf(stderr, "kernel_launch: note: occupancy query reports %d workgroups per CU\n", per_cu);
        (void)hipGetLastError();
        grid = cus;
    }
    if (grid < 0) return;
    if (hipMemsetAsync((char*)d_ws + WS_CTL, 0, CTL_ZERO_BYTES, stream) != hipSuccess) { fprintf(stderr, "kernel_launch: memset failed\n"); return; }
    Args a{};
    for (int i = 0; i < 19; ++i) a.in[i] = (const float*)d_in[i];
    a.out = (float*)d_out; a.ws = (unsigned char*)d_ws;
    hipLaunchKernelGGL(mega_fwd, dim3(grid), dim3(NWAVES * 64), LDS_BYTES, stream, a);
    const hipError_t le = hipPeekAtLastError();
    if (le != hipSuccess) fprintf(stderr, "kernel_launch: launch failed: %s\n", hipGetErrorName(le));
}
```
